# Optimizing an MI355X kernel written in HIP

```python
import jax, jax.numpy as jnp
from jax import lax
import numpy as np

D_MODEL = 2048
BATCH = 8
SEQ = 4096
DEPTH = 4

GRID_W = 64
CTX_LEN = 256
N_BRANCH = 4
BRANCH_W = D_MODEL // N_BRANCH
CHUNK = 128
A_GROUPS = 4
A_GW = BRANCH_W // A_GROUPS
B_HD = 64
B_QH = BRANCH_W // B_HD
B_KVH = B_QH // 4
B_WIN = 128
B_BLK = 128
C_GROUPS = 4
C_GW = BRANCH_W // C_GROUPS
D_HD = 32
D_H = BRANCH_W // D_HD
NA_ROWS = 8
NA_COLS = 16
ROPE_BASE = 10000.0
EPS = 1e-6
NEG = -1e30

PARTS = ("a_u", "a_v", "a_z",
         "b_q", "b_k", "b_v", "b_z",
         "f_in", "f_z",
         "d_q", "d_k", "d_v", "d_z")
IN_SIZES = (BRANCH_W, BRANCH_W, BRANCH_W,
            B_QH * B_HD, B_KVH * B_HD, B_KVH * B_HD, BRANCH_W,
            BRANCH_W, BRANCH_W,
            BRANCH_W, BRANCH_W, BRANCH_W, BRANCH_W)
IN_WIDTH = sum(IN_SIZES)
CTX_KV_PARTS = ("b_k", "b_v", "d_k", "d_v")

kernel_name = "hybrid_gated_parallel_mixer_dit"


def rmsnorm(x, g):
    xf = x.astype(jnp.float32)
    y = xf * lax.rsqrt(jnp.mean(xf * xf, axis=-1, keepdims=True) + EPS)
    return (y * g.astype(jnp.float32)).astype(x.dtype)


def heads(t, n):
    return t.reshape(t.shape[:-1] + (n, -1))


def _rope_1d(x, pos):
    half = x.shape[-1] // 2
    inv = ROPE_BASE ** (-jnp.arange(half, dtype=jnp.float32) / half)
    ang = pos.astype(jnp.float32)[:, None] * inv[None, :]
    cos = jnp.cos(ang)[None, :, None, :]
    sin = jnp.sin(ang)[None, :, None, :]
    xf = x.astype(jnp.float32)
    x1, x2 = xf[..., :half], xf[..., half:]
    return jnp.concatenate([x1 * cos - x2 * sin, x2 * cos + x1 * sin], axis=-1).astype(x.dtype)


def rope_2d(x, pos_r, pos_c):
    d = x.shape[-1] // 2
    return jnp.concatenate([_rope_1d(x[..., :d], pos_r), _rope_1d(x[..., d:], pos_c)], axis=-1)


def project_all(n, w):
    z = n @ w
    offs = [int(o) for o in np.cumsum((0,) + IN_SIZES)]
    return {name: z[..., offs[i]:offs[i + 1]] for i, name in enumerate(PARTS)}


def project_some(n, w, names):
    offs = [int(o) for o in np.cumsum((0,) + IN_SIZES)]
    return {name: n @ w[:, offs[i]:offs[i + 1]] for i, name in enumerate(PARTS) if name in names}


def chunk_mlp(u, v, g_v, w_s, b_s):
    Bn, L, _ = u.shape
    u = jax.nn.gelu(u)
    v = rmsnorm(jax.nn.gelu(v), g_v)
    vb = v.reshape(Bn, L // CHUNK, CHUNK, A_GROUPS, A_GW)
    mixed = jnp.einsum('gts,bnsgc->bntgc', w_s, vb) + b_s.T[None, None, :, :, None]
    return u * mixed.reshape(Bn, L, BRANCH_W)


def fourier_mix(xf_in, w_f):
    Bn, L, _ = xf_in.shape
    xg = xf_in.astype(jnp.float32).reshape(Bn, L, C_GROUPS, C_GW)
    f = jnp.real(jnp.fft.fft2(xg, axes=(1, 3), norm="ortho")).astype(xf_in.dtype)
    return jnp.einsum('blgc,gcd->blgd', f, w_f).reshape(Bn, L, BRANCH_W)


def dense_attn(q, k, v, sink):
    Bn, Lq, Hq, hd = q.shape
    Lk, Hk = k.shape[1], k.shape[2]
    G = Hq // Hk
    qg = q.reshape(Bn, Lq, Hk, G, hd)
    s = jnp.einsum('bqkgd,bjkd->bkgqj', qg, k).astype(jnp.float32) * (hd ** -0.5)
    if sink is not None:
        sk = jnp.broadcast_to(sink.astype(jnp.float32).reshape(1, Hk, G, 1, 1), (Bn, Hk, G, Lq, 1))
        s = jnp.concatenate([s, sk], axis=-1)
    p = jax.nn.softmax(s, axis=-1)[..., :Lk].astype(v.dtype)
    o = jnp.einsum('bkgqj,bjkd->bqkgd', p, v)
    return o.reshape(Bn, Lq, Hq * hd)


def window_gqa(q, k, v, kc, vc, sink):
    Bn, S, Hq, hd = q.shape
    Hk = k.shape[2]
    G = Hq // Hk
    C = kc.shape[1]
    nb = S // B_BLK
    nl = 3 * B_BLK
    scale = hd ** -0.5
    pad = ((0, 0), (B_BLK, B_BLK), (0, 0), (0, 0))
    kp, vp = jnp.pad(k, pad), jnp.pad(v, pad)
    sink_f = sink.astype(jnp.float32).reshape(1, Hk, G, 1, 1)

    def block(i):
        start = i * B_BLK
        qi = lax.dynamic_slice_in_dim(q, start, B_BLK, axis=1).reshape(Bn, B_BLK, Hk, G, hd)
        ki = lax.dynamic_slice_in_dim(kp, start, nl, axis=1)
        vi = lax.dynamic_slice_in_dim(vp, start, nl, axis=1)
        qpos = start + jnp.arange(B_BLK)
        kpos = start - B_BLK + jnp.arange(nl)
        valid = (jnp.abs(kpos[None, :] - qpos[:, None]) <= B_WIN) & (kpos[None, :] >= 0) & (kpos[None, :] < S)
        s_loc = jnp.einsum('bqkgd,bjkd->bkgqj', qi, ki).astype(jnp.float32) * scale
        s_loc = jnp.where(valid, s_loc, NEG)
        s_ctx = jnp.einsum('bqkgd,bckd->bkgqc', qi, kc).astype(jnp.float32) * scale
        sk = jnp.broadcast_to(sink_f, s_loc.shape[:-1] + (1,))
        p = jax.nn.softmax(jnp.concatenate([s_loc, s_ctx, sk], axis=-1), axis=-1).astype(v.dtype)
        o = (jnp.einsum('bkgqj,bjkd->bqkgd', p[..., :nl], vi)
             + jnp.einsum('bkgqc,bckd->bqkgd', p[..., nl:nl + C], vc))
        return o.reshape(Bn, B_BLK, Hq * hd)

    out = lax.map(block, jnp.arange(nb))
    return out.transpose(1, 0, 2, 3).reshape(Bn, S, Hq * hd)


def neighborhood_attn(q, k, v, kc, vc, rpb):
    Bn, S, H, hd = q.shape
    rows = S // GRID_W
    wr = min(NA_ROWS, rows)
    nk = wr * NA_COLS
    scale = hd ** -0.5
    qg = q.reshape(Bn, rows, GRID_W, H, hd)
    kg = k.reshape(Bn, rows, GRID_W, H, hd)
    vg = v.reshape(Bn, rows, GRID_W, H, hd)
    row_start = jnp.clip(jnp.arange(rows) - wr // 2, 0, rows - wr)
    c_idx = jnp.arange(GRID_W)
    col_start = jnp.clip(c_idx - NA_COLS // 2, 0, GRID_W - NA_COLS)
    col_win = col_start[:, None] + jnp.arange(NA_COLS)[None, :]
    dc = col_win - c_idx[:, None] + (NA_COLS - 1)

    def row_block(r):
        r0 = row_start[r]
        krow = lax.dynamic_slice_in_dim(kg, r0, wr, axis=1)
        vrow = lax.dynamic_slice_in_dim(vg, r0, wr, axis=1)
        kn = krow[:, :, col_win]
        vn = vrow[:, :, col_win]
        qr = lax.dynamic_index_in_dim(qg, r, axis=1, keepdims=False)
        dr = r0 + jnp.arange(wr) - r + (NA_ROWS - 1)
        bias = rpb[:, dr[:, None, None], dc[None, :, :]].transpose(0, 2, 1, 3)
        s_loc = jnp.einsum('bqhd,brqjhd->bhqrj', qr, kn).astype(jnp.float32) * scale
        s_loc = s_loc + bias.astype(jnp.float32)[None]
        s_ctx = jnp.einsum('bqhd,bchd->bhqc', qr, kc).astype(jnp.float32) * scale
        logits = jnp.concatenate([s_loc.reshape(Bn, H, GRID_W, nk), s_ctx], axis=-1)
        p = jax.nn.softmax(logits, axis=-1).astype(v.dtype)
        p_loc = p[..., :nk].reshape(Bn, H, GRID_W, wr, NA_COLS)
        o = (jnp.einsum('bhqrj,brqjhd->bqhd', p_loc, vn)
             + jnp.einsum('bhqc,bchd->bqhd', p[..., nk:], vc))
        return o

    out = lax.map(row_block, jnp.arange(rows))
    return out.transpose(1, 0, 2, 3, 4).reshape(Bn, S, H * hd)


def merge_branches(n, ys, zs, w_gate, w_branch, w_out):
    acc = jax.nn.sigmoid(n @ w_gate[0]) * ((ys[0] * jax.nn.silu(zs[0])) @ w_branch[0])
    for b in range(1, N_BRANCH):
        acc = acc + jax.nn.sigmoid(n @ w_gate[b]) * ((ys[b] * jax.nn.silu(zs[b])) @ w_branch[b])
    return acc @ w_out


def setup_inputs(seed: int = 0) -> dict:
    key = jax.random.key(seed)
    ks = jax.random.split(key, 24)
    D = D_MODEL

    def nrm(k, shape, s):
        return jax.random.normal(k, shape, jnp.float32) * s

    return {
        "x": nrm(ks[0], (BATCH, SEQ, D), 1.0),
        "c": nrm(ks[1], (BATCH, D), 1.0),
        "ctx": nrm(ks[2], (BATCH, CTX_LEN, D), 1.0),
        "c_ctx": nrm(ks[3], (D,), 1.0),
        "norm_g": 1.0 + nrm(ks[4], (DEPTH, D), 0.05),
        "w_ada": nrm(ks[5], (DEPTH, D, 3 * D), 0.5 * D ** -0.5),
        "b_ada": nrm(ks[6], (DEPTH, 3 * D), 0.02),
        "w_in": nrm(ks[7], (DEPTH, D, IN_WIDTH), D ** -0.5),
        "a_norm_g": 1.0 + nrm(ks[8], (DEPTH, BRANCH_W), 0.05),
        "a_w_s": nrm(ks[9], (DEPTH, A_GROUPS, CHUNK, CHUNK), CHUNK ** -0.5),
        "a_b_s": 1.0 + nrm(ks[10], (DEPTH, A_GROUPS, CHUNK), 0.1),
        "b_q_g": 1.0 + nrm(ks[11], (DEPTH, B_HD), 0.05),
        "b_k_g": 1.0 + nrm(ks[12], (DEPTH, B_HD), 0.05),
        "b_sink": nrm(ks[13], (DEPTH, B_QH), 0.5),
        "c_w_f": nrm(ks[14], (DEPTH, C_GROUPS, C_GW, C_GW), C_GW ** -0.5),
        "d_q_g": 1.0 + nrm(ks[15], (DEPTH, D_HD), 0.05),
        "d_k_g": 1.0 + nrm(ks[16], (DEPTH, D_HD), 0.05),
        "d_rpb": nrm(ks[17], (DEPTH, D_H, 2 * NA_ROWS - 1, 2 * NA_COLS - 1), 0.1),
        "w_gate": nrm(ks[18], (DEPTH, N_BRANCH, D, D), D ** -0.5),
        "w_branch": nrm(ks[19], (DEPTH, N_BRANCH, BRANCH_W, D), BRANCH_W ** -0.5),
        "w_out": nrm(ks[20], (DEPTH, D, D), D ** -0.5),
    }


def reference(x, c, ctx, c_ctx, norm_g, w_ada, b_ada, w_in, a_norm_g, a_w_s, a_b_s,
              b_q_g, b_k_g, b_sink, c_w_f, d_q_g, d_k_g, d_rpb, w_gate, w_branch, w_out):
    S = x.shape[1]
    t = jnp.arange(S)
    pos_r, pos_c = t // GRID_W, t % GRID_W
    h, hc = x, ctx
    for l in range(DEPTH):
        last = l == DEPTH - 1
        m = jax.nn.silu(c) @ w_ada[l] + b_ada[l]
        mc = jax.nn.silu(c_ctx) @ w_ada[l] + b_ada[l]
        sh, sc, gt = jnp.split(m[:, None, :], 3, axis=-1)
        shc, scc, gtc = jnp.split(mc, 3, axis=-1)
        n = rmsnorm(h, norm_g[l]) * (1.0 + sc) + sh
        nc = rmsnorm(hc, norm_g[l]) * (1.0 + scc) + shc

        z = project_all(n, w_in[l])
        zc = project_some(nc, w_in[l], CTX_KV_PARTS) if last else project_all(nc, w_in[l])

        kBc = rmsnorm(heads(zc["b_k"], B_KVH), b_k_g[l])
        vBc = heads(zc["b_v"], B_KVH)
        kDc = rmsnorm(heads(zc["d_k"], D_H), d_k_g[l])
        vDc = heads(zc["d_v"], D_H)

        qB = rope_2d(rmsnorm(heads(z["b_q"], B_QH), b_q_g[l]), pos_r, pos_c)
        kB = rope_2d(rmsnorm(heads(z["b_k"], B_KVH), b_k_g[l]), pos_r, pos_c)
        vB = heads(z["b_v"], B_KVH)
        qD = rmsnorm(heads(z["d_q"], D_H), d_q_g[l])
        kD = rmsnorm(heads(z["d_k"], D_H), d_k_g[l])
        vD = heads(z["d_v"], D_H)
        y_lat = [chunk_mlp(z["a_u"], z["a_v"], a_norm_g[l], a_w_s[l], a_b_s[l]),
                 window_gqa(qB, kB, vB, kBc, vBc, b_sink[l]),
                 fourier_mix(z["f_in"], c_w_f[l]),
                 neighborhood_attn(qD, kD, vD, kDc, vDc, d_rpb[l])]
        g_lat = [z["a_z"], z["b_z"], z["f_z"], z["d_z"]]
        h_new = h + gt * merge_branches(n, y_lat, g_lat, w_gate[l], w_branch[l], w_out[l])

        if not last:
            qBc = rmsnorm(heads(zc["b_q"], B_QH), b_q_g[l])
            qDc = rmsnorm(heads(zc["d_q"], D_H), d_q_g[l])
            y_ctx = [chunk_mlp(zc["a_u"], zc["a_v"], a_norm_g[l], a_w_s[l], a_b_s[l]),
                     dense_attn(qBc, kBc, vBc, b_sink[l]),
                     fourier_mix(zc["f_in"], c_w_f[l]),
                     dense_attn(qDc, kDc, vDc, None)]
            g_ctx = [zc["a_z"], zc["b_z"], zc["f_z"], zc["d_z"]]
            hc = hc + gtc * merge_branches(nc, y_ctx, g_ctx, w_gate[l], w_branch[l], w_out[l])
        h = h_new
    return h
```

```cpp
#include <hip/hip_runtime.h>
#include <cstdio>
#include <cstdint>

#define GAS __attribute__((address_space(1)))
#define LAS __attribute__((address_space(3)))
typedef unsigned short bf16;
typedef unsigned v4u __attribute__((ext_vector_type(4)));
typedef unsigned v2u __attribute__((ext_vector_type(2)));
typedef float f32x4 __attribute__((ext_vector_type(4)));
typedef float f32x2 __attribute__((ext_vector_type(2)));
typedef short bf16x8 __attribute__((ext_vector_type(8)));

namespace pg8 {
constexpr int BM = 256, BK = 64, HALF = 128, HTB = HALF * BK * 2  , STAGE_BYTES = 8 * HTB, NXCD = 8, WGM = 8;
__host__ __device__ __forceinline__ int lds_byte(int r, int c) { const int st = (r >> 4) * 2 + (c >> 5), rr = r & 15, cc = c & 31, ob = rr * 64 + cc * 2; return st * 1024 + (ob ^ (((ob >> 9) & 1) << 5)); }
__host__ __device__ __forceinline__ void stage_rc(int b, int& R, int& C) { const int st = b / 1024, sb = b % 1024, swz = sb ^ (((sb >> 9) & 1) << 5); R = (st >> 1) * 16 + swz / 64; C = (st & 1) * 32 + (swz % 64) / 2; }
__host__ __device__ __forceinline__ int perm32(int rho) { const int n = rho >> 4, i = rho & 15; return 8 * (i >> 2) + 4 * n + (i & 3); }

struct Unit { int pm, pn; };
struct StaticOrder {
    int nM, nN, nwg, G, c;
    __host__ __device__ __forceinline__ void init(int nM_, int nN_, int G_, int c_) { nM = nM_; nN = nN_; nwg = nM * nN; G = G_; c = c_; }
    __host__ __device__ __forceinline__ bool next(int i, Unit& u) const {
        const long L = (long)i * G + c; if (L >= nwg) return false;
        int wgid = (int)L; { const int q = nwg / NXCD, r = nwg % NXCD, xcd = wgid % NXCD, off = wgid / NXCD; wgid = (xcd < r ? xcd * (q + 1) : r * (q + 1) + (xcd - r) * q) + off; }
        const int nig = WGM * nN, gid = wgid / nig, fm = gid * WGM, gsz = (nM - fm) < WGM ? (nM - fm) : WGM;
        u.pm = fm + ((wgid % nig) % gsz); u.pn = (wgid % nig) / gsz; return true;
    }
};
typedef __bf16 bf16x2_n __attribute__((ext_vector_type(2)));
__device__ __forceinline__ unsigned cvt_pk_bf16(float lo, float hi) { f32x2 v; v.x = lo; v.y = hi; return __builtin_bit_cast(unsigned, __builtin_convertvector(v, bf16x2_n)); }

typedef int i32x4 __attribute__((ext_vector_type(4)));
template <bool I8> struct AccT { typedef f32x4 T; };
template <> struct AccT<true> { typedef i32x4 T; };
template <class Prob, class Epi, bool ALIGN_EPI, bool SP2, class Sched = StaticOrder, bool I8 = false>
__device__ __forceinline__ void gemm_phase(LAS unsigned char* lds, const Prob& P, const Sched& S, const Epi& E) {
    int tid_ = threadIdx.x; asm volatile("" : "+v"(tid_));
    const int tid = tid_, wid = __builtin_amdgcn_readfirstlane(tid >> 6), lane = tid & 63, wr = wid >> 2, wc = wid & 3, fr = lane & 15, fq = lane >> 4;
    const int nt = P.K / BK;
    unsigned voffA[2], voffB[2];
#pragma unroll
    for (int i = 0; i < 2; ++i) { int R, C; stage_rc(tid * 16 + i * 8192, R, C); const int Rb = Epi::PERM ? ((R & ~31) + perm32(R & 31)) : R;
        voffA[i] = (unsigned)R * P.lda + (unsigned)C * 2u; voffB[i] = (unsigned)Rb * P.ldb + (unsigned)C * 2u; }
    const size_t kstep = (size_t)(BK * 2);
    const size_t hstepA = (size_t)HALF * P.lda, hstepB = (size_t)HALF * P.ldb;
    const unsigned ldsw = (unsigned)wid * 1024u;
    const int aoff = lds_byte(wr * 64 + fr, fq * 8), boff = lds_byte(wc * 32 + fr, fq * 8);
#define PG8_SA(b, h) (((b) * 2 + (h)) * HTB)
#define PG8_SB(b, h) ((4 + (b) * 2 + (h)) * HTB)
#define PG8_STAGE(bufoff, gbase, voff) do { _Pragma("unroll") for (int _i = 0; _i < 2; ++_i) \
        __builtin_amdgcn_global_load_lds((const unsigned*)((const char*)(gbase) + (voff)[_i]), (LAS unsigned*)(lds + (bufoff) + ldsw + _i * 8192), 16, 0, 0); } while (0)
#define PG8_LDA(dst, b, h) do { _Pragma("unroll") for (int m = 0; m < 4; ++m) _Pragma("unroll") for (int k = 0; k < 2; ++k) dst[m][k] = *(const LAS bf16x8*)(lds + PG8_SA(b, h) + aoff + m * 2048 + k * 1024); } while (0)
#define PG8_LDB(dst, b, h) do { _Pragma("unroll") for (int n = 0; n < 2; ++n) _Pragma("unroll") for (int k = 0; k < 2; ++k) dst[n][k] = *(const LAS bf16x8*)(lds + PG8_SB(b, h) + boff + n * 2048 + k * 1024); } while (0)
#define PG8_MMA(ai, bj, At, Bt) do { __builtin_amdgcn_s_setprio(1); _Pragma("unroll") for (int m = 0; m < 4; ++m) _Pragma("unroll") for (int n = 0; n < 2; ++n) _Pragma("unroll") for (int k = 0; k < 2; ++k) { \
        if constexpr (I8) asm volatile("v_mfma_i32_16x16x64_i8 %0, %1, %2, %0" : "+v"(acc[ai][bj][m][n]) : "v"(Bt[n][k]), "v"(At[m][k]));   \
        else acc[ai][bj][m][n] = __builtin_amdgcn_mfma_f32_16x16x32_bf16(Bt[n][k], At[m][k], acc[ai][bj][m][n], 0, 0, 0); } __builtin_amdgcn_s_setprio(0); } while (0)
#define PG8_WAIT_V(n) asm volatile("s_waitcnt vmcnt(" #n ")" ::: "memory")
#define PG8_WAIT_L(n) asm volatile("s_waitcnt lgkmcnt(" #n ")" ::: "memory")
#define PG8_BAR __builtin_amdgcn_s_barrier()
#define PG8_SCHED __builtin_amdgcn_sched_barrier(0)
    typedef typename AccT<I8>::T ACC;
    Unit cur, nxt; int ui = 0;
    if (!S.next(0, cur)) return;
    ACC acc[2][2][4][2];
#pragma unroll
    for (int a = 0; a < 2; ++a)
#pragma unroll
        for (int b = 0; b < 2; ++b)
#pragma unroll
            for (int m = 0; m < 4; ++m)
#pragma unroll
                for (int n = 0; n < 2; ++n) acc[a][b][m][n] = (ACC){0, 0, 0, 0};
    bf16x8 At[4][2], B0[2][2], B1[2][2];
    const char* cA = P.a_ptr(cur); const char* cB = P.b_ptr(cur);
    if constexpr (SP2) {
        PG8_STAGE(PG8_SB(0, 0), cB, voffB); PG8_STAGE(PG8_SB(0, 1), cB + hstepB, voffB); PG8_STAGE(PG8_SA(0, 0), cA, voffA); PG8_STAGE(PG8_SA(0, 1), cA + hstepA, voffA);
        if (wr == 1) PG8_BAR;
        PG8_WAIT_V(2); PG8_BAR;
        PG8_STAGE(PG8_SB(1, 0), cB + kstep, voffB); PG8_STAGE(PG8_SA(1, 0), cA + kstep, voffA); PG8_STAGE(PG8_SB(1, 1), cB + hstepB + kstep, voffB);
        PG8_WAIT_V(6); PG8_BAR;
    } else {
        PG8_STAGE(PG8_SB(0, 0), cB, voffB); PG8_STAGE(PG8_SA(0, 0), cA, voffA); PG8_STAGE(PG8_SB(0, 1), cB + hstepB, voffB); PG8_STAGE(PG8_SA(0, 1), cA + hstepA, voffA);
        if (wr == 1) PG8_BAR;
        PG8_WAIT_V(4); PG8_BAR;
        PG8_STAGE(PG8_SB(1, 0), cB + kstep, voffB); PG8_STAGE(PG8_SA(1, 0), cA + kstep, voffA); PG8_STAGE(PG8_SB(1, 1), cB + hstepB + kstep, voffB);
        PG8_WAIT_V(6); PG8_BAR;
    }
    for (;;) {
        const bool has_next = S.next(ui + 1, nxt);
        const char* nA = has_next ? P.a_ptr(nxt) : cA; const char* nB = has_next ? P.b_ptr(nxt) : cB;
        for (int t = 0; t < nt; t += 2) {
            const bool last = (t == nt - 2);
            const char* a1 = cA + (size_t)(t + 1) * kstep;
            const char* a2 = last ? nA : cA + (size_t)(t + 2) * kstep; const char* b2 = last ? nB : cB + (size_t)(t + 2) * kstep;
            const char* a3 = a2 + kstep; const char* b3 = b2 + kstep;
            if constexpr (SP2) {
            PG8_LDB(B0, 0, 0); PG8_LDB(B1, 0, 1); PG8_SCHED; PG8_LDA(At, 0, 0); PG8_STAGE(PG8_SA(1, 1), a1 + hstepA, voffA);
            PG8_WAIT_V(8); PG8_WAIT_L(0); PG8_BAR; PG8_MMA(0, 0, At, B0); PG8_MMA(0, 1, At, B1); PG8_BAR; PG8_SCHED;
            PG8_LDA(At, 0, 1); PG8_STAGE(PG8_SB(0, 0), b2, voffB); PG8_STAGE(PG8_SB(0, 1), b2 + hstepB, voffB); PG8_STAGE(PG8_SA(0, 0), a2, voffA);
            PG8_WAIT_V(8); PG8_WAIT_L(0); PG8_BAR; PG8_MMA(1, 0, At, B0); PG8_MMA(1, 1, At, B1); PG8_BAR; PG8_SCHED;
            PG8_LDB(B0, 1, 0); PG8_LDB(B1, 1, 1); PG8_SCHED; PG8_LDA(At, 1, 0); PG8_STAGE(PG8_SA(0, 1), a2 + hstepA, voffA);
            PG8_WAIT_V(8); PG8_WAIT_L(0); PG8_BAR; PG8_MMA(0, 0, At, B0); PG8_MMA(0, 1, At, B1); PG8_BAR; PG8_SCHED;
            PG8_LDA(At, 1, 1); PG8_STAGE(PG8_SB(1, 0), b3, voffB); PG8_STAGE(PG8_SB(1, 1), b3 + hstepB, voffB); PG8_STAGE(PG8_SA(1, 0), a3, voffA);
            PG8_WAIT_V(8); PG8_WAIT_L(0); PG8_BAR; PG8_MMA(1, 0, At, B0); PG8_MMA(1, 1, At, B1); PG8_BAR; PG8_SCHED;
            } else {
            PG8_LDB(B0, 0, 0); PG8_SCHED; PG8_LDA(At, 0, 0); PG8_STAGE(PG8_SA(1, 1), a1 + hstepA, voffA);
            PG8_WAIT_L(8); PG8_BAR; PG8_WAIT_L(0); PG8_MMA(0, 0, At, B0); PG8_BAR; PG8_SCHED;
            PG8_LDB(B1, 0, 1); PG8_STAGE(PG8_SB(0, 0), b2, voffB);
            PG8_BAR; PG8_WAIT_L(0); PG8_MMA(0, 1, At, B1); PG8_BAR;
            PG8_LDA(At, 0, 1); PG8_STAGE(PG8_SA(0, 0), a2, voffA);
            PG8_BAR; PG8_WAIT_L(0); PG8_MMA(1, 0, At, B0); PG8_BAR; PG8_SCHED;
            PG8_STAGE(PG8_SB(0, 1), b2 + hstepB, voffB);
            PG8_WAIT_V(6); PG8_BAR; PG8_MMA(1, 1, At, B1); PG8_BAR;
            PG8_LDB(B0, 1, 0); PG8_SCHED; PG8_LDA(At, 1, 0); PG8_STAGE(PG8_SA(0, 1), a2 + hstepA, voffA);
            PG8_WAIT_L(8); PG8_BAR; PG8_WAIT_L(0); PG8_MMA(0, 0, At, B0); PG8_BAR; PG8_SCHED;
            PG8_LDB(B1, 1, 1); PG8_STAGE(PG8_SB(1, 0), b3, voffB);
            PG8_BAR; PG8_WAIT_L(0); PG8_MMA(0, 1, At, B1); PG8_BAR;
            PG8_LDA(At, 1, 1); PG8_STAGE(PG8_SA(1, 0), a3, voffA);
            PG8_BAR; PG8_WAIT_L(0); PG8_MMA(1, 0, At, B0); PG8_BAR; PG8_SCHED;
            PG8_STAGE(PG8_SB(1, 1), b3 + hstepB, voffB);
            PG8_WAIT_V(6); PG8_BAR; PG8_MMA(1, 1, At, B1); PG8_BAR;
            }
        }
        if constexpr (ALIGN_EPI) { if (wr == 0) PG8_BAR; }
        E(acc, cur, wr, wc, fr, fq);
        if (!has_next) break;
#pragma unroll
        for (int a = 0; a < 2; ++a)
#pragma unroll
            for (int b = 0; b < 2; ++b)
#pragma unroll
                for (int m = 0; m < 4; ++m)
#pragma unroll
                    for (int n = 0; n < 2; ++n) acc[a][b][m][n] = (ACC){0, 0, 0, 0};
        cur = nxt; cA = nA; cB = nB; ++ui;
        if constexpr (ALIGN_EPI) { if (wr == 1) PG8_BAR; }
    }
    PG8_WAIT_V(0);
    if constexpr (!ALIGN_EPI) { if (wr == 0) PG8_BAR; }
    PG8_BAR;
#undef PG8_SA
#undef PG8_SB
#undef PG8_STAGE
#undef PG8_LDA
#undef PG8_LDB
#undef PG8_MMA
#undef PG8_WAIT_V
#undef PG8_WAIT_L
#undef PG8_BAR
#undef PG8_SCHED
}
}

namespace pg8 {
struct M1Prob {
    const char* Zb; const char* Wb; const unsigned char* G; bf16* T;
    __device__ __forceinline__ const char* a_ptr(int pm, int b) const { const int yc = (b == 0) ? 0 : ((b == 1) ? 1536 : ((b == 2) ? 2816 : 3840)); return Zb + ((size_t)pm * 256 * 5888 + yc) * 2; }
    __device__ __forceinline__ const char* b_ptr(int pn, int b) const { return Wb + ((size_t)b * 2048 + (size_t)pn * 128) * 512 * 2; }
    __device__ __forceinline__ const char* a_ptr128(int pm, int b) const { const int yc = (b == 0) ? 0 : ((b == 1) ? 1536 : ((b == 2) ? 2816 : 3840)); return Zb + ((size_t)pm * 128 * 5888 + yc) * 2; }
    __device__ __forceinline__ const char* b_ptr256(int pn, int b) const { return Wb + ((size_t)b * 2048 + (size_t)pn * 256) * 512 * 2; }
};
__device__ __forceinline__ void gemm_phase_m1(LAS unsigned char* lds, const M1Prob& P, int G, int c, int npanels) {
    int tid_ = threadIdx.x; asm volatile("" : "+v"(tid_));
    const int tid = tid_, wid = __builtin_amdgcn_readfirstlane(tid >> 6), lane = tid & 63, wr = wid >> 2, wc = wid & 3, fr = lane & 15, fq = lane >> 4;
    constexpr int K = 512, nt = K / BK; constexpr unsigned lda = 5888 * 2, ldb = 512 * 2;
    unsigned voffA[2], voffB[2];
#pragma unroll
    for (int i = 0; i < 2; ++i) { int R, C; stage_rc(tid * 16 + i * 8192, R, C); const int Rb = (R & ~31) + perm32(R & 31);
        voffA[i] = (unsigned)R * lda + (unsigned)C * 2u; voffB[i] = (unsigned)Rb * ldb + (unsigned)C * 2u; }
    const size_t kstep = (size_t)(BK * 2);
    const size_t hstepA = (size_t)HALF * lda;
    const unsigned ldsw = (unsigned)wid * 1024u;
    const int aoff = lds_byte(wr * 64 + fr, fq * 8), boff = lds_byte(wc * 32 + fr, fq * 8);
#define PG8_SA(b, h) (((b) * 2 + (h)) * HTB)
#define PG8_SB(b) ((4 + (b) * 2) * HTB)
#define PG8_STAGE(bufoff, gbase, voff) do { _Pragma("unroll") for (int _i = 0; _i < 2; ++_i) \
        __builtin_amdgcn_global_load_lds((const unsigned*)((const char*)(gbase) + (voff)[_i]), (LAS unsigned*)(lds + (bufoff) + ldsw + _i * 8192), 16, 0, 0); } while (0)
#define PG8_LDA(dst, b, h) do { _Pragma("unroll") for (int m = 0; m < 4; ++m) _Pragma("unroll") for (int k = 0; k < 2; ++k) dst[m][k] = *(const LAS bf16x8*)(lds + PG8_SA(b, h) + aoff + m * 2048 + k * 1024); } while (0)
#define PG8_LDB(dst, b) do { _Pragma("unroll") for (int n = 0; n < 2; ++n) _Pragma("unroll") for (int k = 0; k < 2; ++k) dst[n][k] = *(const LAS bf16x8*)(lds + PG8_SB(b) + boff + n * 2048 + k * 1024); } while (0)
#define PG8_MMA(ai, At, Bt) do { __builtin_amdgcn_s_setprio(1); _Pragma("unroll") for (int m = 0; m < 4; ++m) _Pragma("unroll") for (int n = 0; n < 2; ++n) _Pragma("unroll") for (int k = 0; k < 2; ++k) \
        acc[ai][m][n] = __builtin_amdgcn_mfma_f32_16x16x32_bf16(Bt[n][k], At[m][k], acc[ai][m][n], 0, 0, 0); __builtin_amdgcn_s_setprio(0); } while (0)
#define PG8_WAIT_V(n) asm volatile("s_waitcnt vmcnt(" #n ")" ::: "memory")
#define PG8_WAIT_L(n) asm volatile("s_waitcnt lgkmcnt(" #n ")" ::: "memory")
#define PG8_BAR __builtin_amdgcn_s_barrier()
#define PG8_SCHED __builtin_amdgcn_sched_barrier(0)
    StaticOrder S; S.init(npanels, 16, G, c);
    Unit cur, nxt; int ui = 0;
    if (!S.next(0, cur)) return;
    f32x4 acc[2][4][2], tot[2][4][2];
#pragma unroll
    for (int a = 0; a < 2; ++a)
#pragma unroll
        for (int m = 0; m < 4; ++m)
#pragma unroll
            for (int n = 0; n < 2; ++n) { acc[a][m][n] = (f32x4){0.f, 0.f, 0.f, 0.f}; tot[a][m][n] = (f32x4){0.f, 0.f, 0.f, 0.f}; }
    bf16x8 At[4][2], B0[2][2];
    v2u gq[2][4];
    const char* cA = P.a_ptr(cur.pm, 0); const char* cB = P.b_ptr(cur.pn, 0);
    PG8_STAGE(PG8_SB(0), cB, voffB); PG8_STAGE(PG8_SA(0, 0), cA, voffA); PG8_STAGE(PG8_SA(0, 1), cA + hstepA, voffA);
    if (wr == 1) PG8_BAR;
    PG8_WAIT_V(2); PG8_BAR;
    PG8_STAGE(PG8_SB(1), cB + kstep, voffB); PG8_STAGE(PG8_SA(1, 0), cA + kstep, voffA);
    PG8_WAIT_V(4); PG8_BAR;
    for (;;) {
        const int b = ui & 3;
        bool has_next = true;
        if (b == 3) has_next = S.next((ui >> 2) + 1, nxt); else nxt = cur;
        const int nb = (b + 1) & 3;
        const char* nA = has_next ? P.a_ptr(nxt.pm, nb) : cA; const char* nB = has_next ? P.b_ptr(nxt.pn, nb) : cB;
#pragma unroll 1
        for (int t = 0; t < nt; t += 2) {
            const bool last = (t == nt - 2);
            const char* a1 = cA + (size_t)(t + 1) * kstep;
            const char* a2 = last ? nA : cA + (size_t)(t + 2) * kstep; const char* b2 = last ? nB : cB + (size_t)(t + 2) * kstep;
            const char* a3 = a2 + kstep; const char* b3 = b2 + kstep;
            if (t == 2) {
                const unsigned char* gp = P.G + (size_t)(cur.pm * 256 + wr * 64 + fr) * 8192 + b * 2048 + cur.pn * 128 + wc * 32 + 8 * fq;
#pragma unroll
                for (int ai = 0; ai < 2; ++ai)
#pragma unroll
                    for (int m = 0; m < 4; ++m) { const unsigned char* q = gp + (size_t)(ai * 128 + m * 16) * 8192; asm volatile("global_load_dwordx2 %0, %1, off" : "=v"(gq[ai][m]) : "v"(q) : "memory"); }
            }
            PG8_LDB(B0, 0); PG8_SCHED; PG8_LDA(At, 0, 0); PG8_STAGE(PG8_SA(1, 1), a1 + hstepA, voffA);
            PG8_WAIT_V(6); PG8_WAIT_L(0); PG8_BAR; PG8_MMA(0, At, B0); PG8_BAR; PG8_SCHED;
            PG8_LDA(At, 0, 1); PG8_STAGE(PG8_SB(0), b2, voffB); PG8_STAGE(PG8_SA(0, 0), a2, voffA);
            PG8_WAIT_V(6); PG8_WAIT_L(0); PG8_BAR; PG8_MMA(1, At, B0); PG8_BAR; PG8_SCHED;
            PG8_LDB(B0, 1); PG8_SCHED; PG8_LDA(At, 1, 0); PG8_STAGE(PG8_SA(0, 1), a2 + hstepA, voffA);
            PG8_WAIT_V(6); PG8_WAIT_L(0); PG8_BAR; PG8_MMA(0, At, B0); PG8_BAR; PG8_SCHED;
            PG8_LDA(At, 1, 1); PG8_STAGE(PG8_SB(1), b3, voffB); PG8_STAGE(PG8_SA(1, 0), a3, voffA);
            PG8_WAIT_V(6); PG8_WAIT_L(0); PG8_BAR; PG8_MMA(1, At, B0); PG8_BAR; PG8_SCHED;
        }
        if (wr == 0) PG8_BAR;
        {
            const int row0 = cur.pm * 256 + wr * 64 + fr, col = cur.pn * 128 + wc * 32 + 8 * fq;
#pragma unroll
            for (int ai = 0; ai < 2; ++ai)
#pragma unroll
                for (int m = 0; m < 4; ++m) { const size_t row = (size_t)(row0 + ai * 128 + m * 16);
#pragma unroll
                    for (int n = 0; n < 2; ++n) { const unsigned w = n ? gq[ai][m].y : gq[ai][m].x;
#pragma unroll
                        for (int j = 0; j < 4; ++j) { const float g = (float)((w >> (8 * j)) & 255u) * (1.0f / 255.0f); tot[ai][m][n][j] += g * acc[ai][m][n][j]; } }
                    if (b == 3) { v4u o; o.x = cvt_pk_bf16(tot[ai][m][0][0], tot[ai][m][0][1]); o.y = cvt_pk_bf16(tot[ai][m][0][2], tot[ai][m][0][3]); o.z = cvt_pk_bf16(tot[ai][m][1][0], tot[ai][m][1][1]); o.w = cvt_pk_bf16(tot[ai][m][1][2], tot[ai][m][1][3]);
                        *(v4u*)(P.T + row * 2048 + col) = o; tot[ai][m][0] = (f32x4){0.f, 0.f, 0.f, 0.f}; tot[ai][m][1] = (f32x4){0.f, 0.f, 0.f, 0.f}; }
                    acc[ai][m][0] = (f32x4){0.f, 0.f, 0.f, 0.f}; acc[ai][m][1] = (f32x4){0.f, 0.f, 0.f, 0.f}; }
        }
        if (!has_next) break;
        cur = nxt; cA = nA; cB = nB; ++ui;
        if (wr == 1) PG8_BAR;
    }
    PG8_WAIT_V(0);
    PG8_BAR;
#undef PG8_SA
#undef PG8_SB
#undef PG8_STAGE
#undef PG8_LDA
#undef PG8_LDB
#undef PG8_MMA
#undef PG8_WAIT_V
#undef PG8_WAIT_L
#undef PG8_BAR
#undef PG8_SCHED
}
__device__ __forceinline__ void gemm_phase_m1ms(LAS unsigned char* lds, const M1Prob& P, int G, int c, int npanels) {
    int tid_ = threadIdx.x; asm volatile("" : "+v"(tid_));
    const int tid = tid_, wid = __builtin_amdgcn_readfirstlane(tid >> 6), lane = tid & 63, wr = wid >> 2, wc = wid & 3, fr = lane & 15, fq = lane >> 4;
    constexpr int K = 512, nt = K / BK; constexpr unsigned lda = 5888 * 2, ldb = 512 * 2;
    unsigned voffA[2], voffB[2];
#pragma unroll
    for (int i = 0; i < 2; ++i) { int R, C; stage_rc(tid * 16 + i * 8192, R, C); const int Rb = (R & ~31) + perm32(R & 31);
        voffA[i] = (unsigned)R * lda + (unsigned)C * 2u; voffB[i] = (unsigned)Rb * ldb + (unsigned)C * 2u; }
    const size_t kstep = (size_t)(BK * 2);
    const size_t hstepB = (size_t)HALF * ldb;
    const unsigned ldsw = (unsigned)wid * 1024u;
    const int aoff = lds_byte(wr * 64 + fr, fq * 8), boff = lds_byte(wc * 32 + fr, fq * 8);
#define PG8_SA(b) (((b) * 2) * HTB)
#define PG8_SB(b, h) ((4 + (b) * 2 + (h)) * HTB)
#define PG8_STAGE(bufoff, gbase, voff) do { _Pragma("unroll") for (int _i = 0; _i < 2; ++_i) \
        __builtin_amdgcn_global_load_lds((const unsigned*)((const char*)(gbase) + (voff)[_i]), (LAS unsigned*)(lds + (bufoff) + ldsw + _i * 8192), 16, 0, 0); } while (0)
#define PG8_LDA(dst, b) do { _Pragma("unroll") for (int m = 0; m < 4; ++m) _Pragma("unroll") for (int k = 0; k < 2; ++k) dst[m][k] = *(const LAS bf16x8*)(lds + PG8_SA(b) + aoff + m * 2048 + k * 1024); } while (0)
#define PG8_LDB(dst, b, h) do { _Pragma("unroll") for (int n = 0; n < 2; ++n) _Pragma("unroll") for (int k = 0; k < 2; ++k) dst[n][k] = *(const LAS bf16x8*)(lds + PG8_SB(b, h) + boff + n * 2048 + k * 1024); } while (0)
#define PG8_MMA(ai, At, Bt) do { __builtin_amdgcn_s_setprio(1); _Pragma("unroll") for (int m = 0; m < 4; ++m) _Pragma("unroll") for (int n = 0; n < 2; ++n) _Pragma("unroll") for (int k = 0; k < 2; ++k) \
        acc[ai][m][n] = __builtin_amdgcn_mfma_f32_16x16x32_bf16(Bt[n][k], At[m][k], acc[ai][m][n], 0, 0, 0); __builtin_amdgcn_s_setprio(0); } while (0)
#define PG8_WAIT_V(n) asm volatile("s_waitcnt vmcnt(" #n ")" ::: "memory")
#define PG8_WAIT_L(n) asm volatile("s_waitcnt lgkmcnt(" #n ")" ::: "memory")
#define PG8_BAR __builtin_amdgcn_s_barrier()
#define PG8_SCHED __builtin_amdgcn_sched_barrier(0)
    StaticOrder S; S.init(npanels * 2, 8, G, c);
    Unit cur, nxt; int ui = 0;
    if (!S.next(0, cur)) return;
    f32x4 acc[2][4][2], tot[2][4][2];
#pragma unroll
    for (int a = 0; a < 2; ++a)
#pragma unroll
        for (int m = 0; m < 4; ++m)
#pragma unroll
            for (int n = 0; n < 2; ++n) { acc[a][m][n] = (f32x4){0.f, 0.f, 0.f, 0.f}; tot[a][m][n] = (f32x4){0.f, 0.f, 0.f, 0.f}; }
    bf16x8 At[4][2], B0[2][2];
    v2u gq[2][4];
    const char* cA = P.a_ptr128(cur.pm, 0); const char* cB = P.b_ptr256(cur.pn, 0);
    PG8_STAGE(PG8_SA(0), cA, voffA); PG8_STAGE(PG8_SB(0, 0), cB, voffB); PG8_STAGE(PG8_SB(0, 1), cB + hstepB, voffB);
    if (wr == 1) PG8_BAR;
    PG8_WAIT_V(2); PG8_BAR;
    PG8_STAGE(PG8_SA(1), cA + kstep, voffA); PG8_STAGE(PG8_SB(1, 0), cB + kstep, voffB);
    PG8_WAIT_V(4); PG8_BAR;
    for (;;) {
        const int b = ui & 3;
        bool has_next = true;
        if (b == 3) has_next = S.next((ui >> 2) + 1, nxt); else nxt = cur;
        const int nb = (b + 1) & 3;
        const char* nA = has_next ? P.a_ptr128(nxt.pm, nb) : cA; const char* nB = has_next ? P.b_ptr256(nxt.pn, nb) : cB;
#pragma unroll 1
        for (int t = 0; t < nt; t += 2) {
            const bool last = (t == nt - 2);
            const char* b1 = cB + (size_t)(t + 1) * kstep;
            const char* a2 = last ? nA : cA + (size_t)(t + 2) * kstep; const char* b2 = last ? nB : cB + (size_t)(t + 2) * kstep;
            const char* a3 = a2 + kstep; const char* b3 = b2 + kstep;
            if (t == 2) {
                const unsigned char* gp = P.G + (size_t)(cur.pm * 128 + wr * 64 + fr) * 8192 + b * 2048 + cur.pn * 256 + wc * 32 + 8 * fq;
#pragma unroll
                for (int ai = 0; ai < 2; ++ai)
#pragma unroll
                    for (int m = 0; m < 4; ++m) { const unsigned char* q = gp + (size_t)(m * 16) * 8192 + ai * 128; asm volatile("global_load_dwordx2 %0, %1, off" : "=v"(gq[ai][m]) : "v"(q) : "memory"); }
            }
            PG8_LDA(At, 0); PG8_SCHED; PG8_LDB(B0, 0, 0); PG8_STAGE(PG8_SB(1, 1), b1 + hstepB, voffB);
            PG8_WAIT_V(6); PG8_WAIT_L(0); PG8_BAR; PG8_MMA(0, At, B0); PG8_BAR; PG8_SCHED;
            PG8_LDB(B0, 0, 1); PG8_STAGE(PG8_SA(0), a2, voffA); PG8_STAGE(PG8_SB(0, 0), b2, voffB);
            PG8_WAIT_V(6); PG8_WAIT_L(0); PG8_BAR; PG8_MMA(1, At, B0); PG8_BAR; PG8_SCHED;
            PG8_LDA(At, 1); PG8_SCHED; PG8_LDB(B0, 1, 0); PG8_STAGE(PG8_SB(0, 1), b2 + hstepB, voffB);
            PG8_WAIT_V(6); PG8_WAIT_L(0); PG8_BAR; PG8_MMA(0, At, B0); PG8_BAR; PG8_SCHED;
            PG8_LDB(B0, 1, 1); PG8_STAGE(PG8_SA(1), a3, voffA); PG8_STAGE(PG8_SB(1, 0), b3, voffB);
            PG8_WAIT_V(6); PG8_WAIT_L(0); PG8_BAR; PG8_MMA(1, At, B0); PG8_BAR; PG8_SCHED;
        }
        if (wr == 0) PG8_BAR;
        {
            const int row0 = cur.pm * 128 + wr * 64 + fr, col0 = cur.pn * 256 + wc * 32 + 8 * fq;
#pragma unroll
            for (int ai = 0; ai < 2; ++ai)
#pragma unroll
                for (int m = 0; m < 4; ++m) { const size_t row = (size_t)(row0 + m * 16); const int col = col0 + ai * 128;
#pragma unroll
                    for (int n = 0; n < 2; ++n) { const unsigned w = n ? gq[ai][m].y : gq[ai][m].x;
#pragma unroll
                        for (int j = 0; j < 4; ++j) { const float g = (float)((w >> (8 * j)) & 255u) * (1.0f / 255.0f); tot[ai][m][n][j] += g * acc[ai][m][n][j]; } }
                    if (b == 3) { v4u o; o.x = cvt_pk_bf16(tot[ai][m][0][0], tot[ai][m][0][1]); o.y = cvt_pk_bf16(tot[ai][m][0][2], tot[ai][m][0][3]); o.z = cvt_pk_bf16(tot[ai][m][1][0], tot[ai][m][1][1]); o.w = cvt_pk_bf16(tot[ai][m][1][2], tot[ai][m][1][3]);
                        *(v4u*)(P.T + row * 2048 + col) = o; tot[ai][m][0] = (f32x4){0.f, 0.f, 0.f, 0.f}; tot[ai][m][1] = (f32x4){0.f, 0.f, 0.f, 0.f}; }
                    acc[ai][m][0] = (f32x4){0.f, 0.f, 0.f, 0.f}; acc[ai][m][1] = (f32x4){0.f, 0.f, 0.f, 0.f}; }
        }
        if (!has_next) break;
        cur = nxt; cA = nA; cB = nB; ++ui;
        if (wr == 1) PG8_BAR;
    }
    PG8_WAIT_V(0);
    PG8_BAR;
#undef PG8_SA
#undef PG8_SB
#undef PG8_STAGE
#undef PG8_LDA
#undef PG8_LDB
#undef PG8_MMA
#undef PG8_WAIT_V
#undef PG8_WAIT_L
#undef PG8_BAR
#undef PG8_SCHED
}
template <class Epi>
__device__ __forceinline__ void gemm_phase_half(LAS unsigned char* lds, const char* cA, const char* cB, unsigned lda, unsigned ldb, int K, bool active, const Epi& E, int rowbase, int pn) {
    int tid_ = threadIdx.x; asm volatile("" : "+v"(tid_));
    const int tid = tid_, wid = __builtin_amdgcn_readfirstlane(tid >> 6), lane = tid & 63, wr = wid >> 2, wc = wid & 3, fr = lane & 15, fq = lane >> 4;
    if (!active) return;
    const int nt = K / BK;
    unsigned voffA[2], voffB[2];
#pragma unroll
    for (int i = 0; i < 2; ++i) { int R, C; stage_rc(tid * 16 + i * 8192, R, C); const int Rb = Epi::PERM ? ((R & ~31) + perm32(R & 31)) : R;
        voffA[i] = (unsigned)R * lda + (unsigned)C * 2u; voffB[i] = (unsigned)Rb * ldb + (unsigned)C * 2u; }
    const size_t kstep = (size_t)(BK * 2);
    const size_t hstepB = (size_t)HALF * ldb;
    const unsigned ldsw = (unsigned)wid * 1024u;
    const int aoff = lds_byte(wr * 64 + fr, fq * 8), boff = lds_byte(wc * 32 + fr, fq * 8);
#define PG8_SA(b) (((b) * 2) * HTB)
#define PG8_SB(b, h) ((4 + (b) * 2 + (h)) * HTB)
#define PG8_STAGE(bufoff, gbase, voff) do { _Pragma("unroll") for (int _i = 0; _i < 2; ++_i) \
        __builtin_amdgcn_global_load_lds((const unsigned*)((const char*)(gbase) + (voff)[_i]), (LAS unsigned*)(lds + (bufoff) + ldsw + _i * 8192), 16, 0, 0); } while (0)
#define PG8_LDA(dst, b) do { _Pragma("unroll") for (int m = 0; m < 4; ++m) _Pragma("unroll") for (int k = 0; k < 2; ++k) dst[m][k] = *(const LAS bf16x8*)(lds + PG8_SA(b) + aoff + m * 2048 + k * 1024); } while (0)
#define PG8_LDB(dst, b, h) do { _Pragma("unroll") for (int n = 0; n < 2; ++n) _Pragma("unroll") for (int k = 0; k < 2; ++k) dst[n][k] = *(const LAS bf16x8*)(lds + PG8_SB(b, h) + boff + n * 2048 + k * 1024); } while (0)
#define PG8_MMA(ai, At, Bt) do { __builtin_amdgcn_s_setprio(1); _Pragma("unroll") for (int m = 0; m < 4; ++m) _Pragma("unroll") for (int n = 0; n < 2; ++n) _Pragma("unroll") for (int k = 0; k < 2; ++k) \
        acc[0][ai][m][n] = __builtin_amdgcn_mfma_f32_16x16x32_bf16(Bt[n][k], At[m][k], acc[0][ai][m][n], 0, 0, 0); __builtin_amdgcn_s_setprio(0); } while (0)
#define PG8_WAIT_V(n) asm volatile("s_waitcnt vmcnt(" #n ")" ::: "memory")
#define PG8_WAIT_L(n) asm volatile("s_waitcnt lgkmcnt(" #n ")" ::: "memory")
#define PG8_BAR __builtin_amdgcn_s_barrier()
#define PG8_SCHED __builtin_amdgcn_sched_barrier(0)
    f32x4 acc[1][2][4][2];
#pragma unroll
    for (int a = 0; a < 2; ++a)
#pragma unroll
        for (int m = 0; m < 4; ++m)
#pragma unroll
            for (int n = 0; n < 2; ++n) acc[0][a][m][n] = (f32x4){0.f, 0.f, 0.f, 0.f};
    bf16x8 At[4][2], B0[2][2];
    PG8_STAGE(PG8_SA(0), cA, voffA); PG8_STAGE(PG8_SB(0, 0), cB, voffB); PG8_STAGE(PG8_SB(0, 1), cB + hstepB, voffB);
    if (wr == 1) PG8_BAR;
    PG8_WAIT_V(2); PG8_BAR;
    PG8_STAGE(PG8_SA(1), cA + kstep, voffA); PG8_STAGE(PG8_SB(1, 0), cB + kstep, voffB);
    PG8_WAIT_V(4); PG8_BAR;
#pragma unroll 1
    for (int t = 0; t < nt; t += 2) {
        const bool last = (t == nt - 2);
        const char* b1 = cB + (size_t)(t + 1) * kstep;
        const char* a2 = last ? cA : cA + (size_t)(t + 2) * kstep; const char* b2 = last ? cB : cB + (size_t)(t + 2) * kstep;
        const char* a3 = a2 + kstep; const char* b3 = b2 + kstep;
        PG8_LDA(At, 0); PG8_SCHED; PG8_LDB(B0, 0, 0); PG8_STAGE(PG8_SB(1, 1), b1 + hstepB, voffB);
        PG8_WAIT_V(6); PG8_WAIT_L(0); PG8_BAR; PG8_MMA(0, At, B0); PG8_BAR; PG8_SCHED;
        PG8_LDB(B0, 0, 1); PG8_STAGE(PG8_SA(0), a2, voffA); PG8_STAGE(PG8_SB(0, 0), b2, voffB);
        PG8_WAIT_V(6); PG8_WAIT_L(0); PG8_BAR; PG8_MMA(1, At, B0); PG8_BAR; PG8_SCHED;
        PG8_LDA(At, 1); PG8_SCHED; PG8_LDB(B0, 1, 0); PG8_STAGE(PG8_SB(0, 1), b2 + hstepB, voffB);
        PG8_WAIT_V(6); PG8_WAIT_L(0); PG8_BAR; PG8_MMA(0, At, B0); PG8_BAR; PG8_SCHED;
        PG8_LDB(B0, 1, 1); PG8_STAGE(PG8_SA(1), a3, voffA); PG8_STAGE(PG8_SB(1, 0), b3, voffB);
        PG8_WAIT_V(6); PG8_WAIT_L(0); PG8_BAR; PG8_MMA(1, At, B0); PG8_BAR; PG8_SCHED;
    }
    if (wr == 0) PG8_BAR;
    E.template run<1>(acc, rowbase, pn, wr, wc, fr, fq);
    PG8_WAIT_V(0);
    PG8_BAR;
#undef PG8_SA
#undef PG8_SB
#undef PG8_STAGE
#undef PG8_LDA
#undef PG8_LDB
#undef PG8_MMA
#undef PG8_WAIT_V
#undef PG8_WAIT_L
#undef PG8_BAR
#undef PG8_SCHED
}
struct C2Prob {
    const char* cs; const char* sn; const char* fc; const char* fs; const float* uch; bf16* Z; float scale;
    __device__ __forceinline__ const char* a_ptr(int pm, int sub) const { return (sub ? sn : cs) + (size_t)(pm & 7) * 256 * 2048 * 2; }
    __device__ __forceinline__ const char* b_ptr(int pm, int pn, int sub) const { return (sub ? fs : fc) + ((size_t)(pm >> 3) * 512 + (size_t)pn * 128) * 2048 * 2; }
};
__device__ __forceinline__ void gemm_phase_c2(LAS unsigned char* lds, const C2Prob& P, int G, int c) {
    int tid_ = threadIdx.x; asm volatile("" : "+v"(tid_));
    const int tid = tid_, wid = __builtin_amdgcn_readfirstlane(tid >> 6), lane = tid & 63, wr = wid >> 2, wc = wid & 3, fr = lane & 15, fq = lane >> 4;
    constexpr int K = 2048, nt = K / BK; constexpr unsigned lda = 2048 * 2, ldb = 2048 * 2;
    unsigned voffA[2], voffB[2];
#pragma unroll
    for (int i = 0; i < 2; ++i) { int R, C; stage_rc(tid * 16 + i * 8192, R, C); const int Rb = (R & ~31) + perm32(R & 31);
        voffA[i] = (unsigned)R * lda + (unsigned)C * 2u; voffB[i] = (unsigned)Rb * ldb + (unsigned)C * 2u; }
    const size_t kstep = (size_t)(BK * 2);
    const size_t hstepA = (size_t)HALF * lda;
    const unsigned ldsw = (unsigned)wid * 1024u;
    const int aoff = lds_byte(wr * 64 + fr, fq * 8), boff = lds_byte(wc * 32 + fr, fq * 8);
#define PG8_SA(b, h) (((b) * 2 + (h)) * HTB)
#define PG8_SB(b) ((4 + (b) * 2) * HTB)
#define PG8_STAGE(bufoff, gbase, voff) do { _Pragma("unroll") for (int _i = 0; _i < 2; ++_i) \
        __builtin_amdgcn_global_load_lds((const unsigned*)((const char*)(gbase) + (voff)[_i]), (LAS unsigned*)(lds + (bufoff) + ldsw + _i * 8192), 16, 0, 0); } while (0)
#define PG8_LDA(dst, b, h) do { _Pragma("unroll") for (int m = 0; m < 4; ++m) _Pragma("unroll") for (int k = 0; k < 2; ++k) dst[m][k] = *(const LAS bf16x8*)(lds + PG8_SA(b, h) + aoff + m * 2048 + k * 1024); } while (0)
#define PG8_LDB(dst, b) do { _Pragma("unroll") for (int n = 0; n < 2; ++n) _Pragma("unroll") for (int k = 0; k < 2; ++k) dst[n][k] = *(const LAS bf16x8*)(lds + PG8_SB(b) + boff + n * 2048 + k * 1024); } while (0)
#define PG8_MMA(ai, At, Bt) do { __builtin_amdgcn_s_setprio(1); _Pragma("unroll") for (int m = 0; m < 4; ++m) _Pragma("unroll") for (int n = 0; n < 2; ++n) _Pragma("unroll") for (int k = 0; k < 2; ++k) \
        acc[ai][m][n] = __builtin_amdgcn_mfma_f32_16x16x32_bf16(Bt[n][k], At[m][k], acc[ai][m][n], 0, 0, 0); __builtin_amdgcn_s_setprio(0); } while (0)
#define PG8_WAIT_V(n) asm volatile("s_waitcnt vmcnt(" #n ")" ::: "memory")
#define PG8_WAIT_L(n) asm volatile("s_waitcnt lgkmcnt(" #n ")" ::: "memory")
#define PG8_BAR __builtin_amdgcn_s_barrier()
#define PG8_SCHED __builtin_amdgcn_sched_barrier(0)
    StaticOrder S; S.init(64, 4, G, c);
    Unit cur, nxt; int ui = 0;
    if (!S.next(0, cur)) return;
    f32x4 acc[2][4][2], tot[2][4][2];
#pragma unroll
    for (int a = 0; a < 2; ++a)
#pragma unroll
        for (int m = 0; m < 4; ++m)
#pragma unroll
            for (int n = 0; n < 2; ++n) { acc[a][m][n] = (f32x4){0.f, 0.f, 0.f, 0.f}; tot[a][m][n] = (f32x4){0.f, 0.f, 0.f, 0.f}; }
    bf16x8 At[4][2], B0[2][2];
    const char* cA = P.a_ptr(cur.pm, 0); const char* cB = P.b_ptr(cur.pm, cur.pn, 0);
    PG8_STAGE(PG8_SB(0), cB, voffB); PG8_STAGE(PG8_SA(0, 0), cA, voffA); PG8_STAGE(PG8_SA(0, 1), cA + hstepA, voffA);
    if (wr == 1) PG8_BAR;
    PG8_WAIT_V(2); PG8_BAR;
    PG8_STAGE(PG8_SB(1), cB + kstep, voffB); PG8_STAGE(PG8_SA(1, 0), cA + kstep, voffA);
    PG8_WAIT_V(4); PG8_BAR;
    for (;;) {
        const int b = ui & 1;
        bool has_next = true;
        if (b == 1) has_next = S.next((ui >> 1) + 1, nxt); else nxt = cur;
        const int nb = (b + 1) & 1;
        const char* nA = has_next ? P.a_ptr(nxt.pm, nb) : cA; const char* nB = has_next ? P.b_ptr(nxt.pm, nxt.pn, nb) : cB;
#pragma unroll 1
        for (int t = 0; t < nt; t += 2) {
            const bool last = (t == nt - 2);
            const char* a1 = cA + (size_t)(t + 1) * kstep;
            const char* a2 = last ? nA : cA + (size_t)(t + 2) * kstep; const char* b2 = last ? nB : cB + (size_t)(t + 2) * kstep;
            const char* a3 = a2 + kstep; const char* b3 = b2 + kstep;
            PG8_LDB(B0, 0); PG8_SCHED; PG8_LDA(At, 0, 0); PG8_STAGE(PG8_SA(1, 1), a1 + hstepA, voffA);
            PG8_WAIT_V(6); PG8_WAIT_L(0); PG8_BAR; PG8_MMA(0, At, B0); PG8_BAR; PG8_SCHED;
            PG8_LDA(At, 0, 1); PG8_STAGE(PG8_SB(0), b2, voffB); PG8_STAGE(PG8_SA(0, 0), a2, voffA);
            PG8_WAIT_V(6); PG8_WAIT_L(0); PG8_BAR; PG8_MMA(1, At, B0); PG8_BAR; PG8_SCHED;
            PG8_LDB(B0, 1); PG8_SCHED; PG8_LDA(At, 1, 0); PG8_STAGE(PG8_SA(0, 1), a2 + hstepA, voffA);
            PG8_WAIT_V(6); PG8_WAIT_L(0); PG8_BAR; PG8_MMA(0, At, B0); PG8_BAR; PG8_SCHED;
            PG8_LDA(At, 1, 1); PG8_STAGE(PG8_SB(1), b3, voffB); PG8_STAGE(PG8_SA(1, 0), a3, voffA);
            PG8_WAIT_V(6); PG8_WAIT_L(0); PG8_BAR; PG8_MMA(1, At, B0); PG8_BAR; PG8_SCHED;
        }
        if (wr == 0) PG8_BAR;
        if (b == 0) {
#pragma unroll
            for (int ai = 0; ai < 2; ++ai)
#pragma unroll
                for (int m = 0; m < 4; ++m)
#pragma unroll
                    for (int n = 0; n < 2; ++n) { tot[ai][m][n] = acc[ai][m][n]; acc[ai][m][n] = (f32x4){0.f, 0.f, 0.f, 0.f}; }
        } else {
            const int bb = cur.pm >> 3, k0 = (cur.pm & 7) * 256 + wr * 64 + fr, d0 = cur.pn * 128 + wc * 32 + 8 * fq;
            const f32x4 e0 = *(const f32x4*)(P.uch + bb * 512 + d0), e1 = *(const f32x4*)(P.uch + bb * 512 + d0 + 4);
#pragma unroll
            for (int ai = 0; ai < 2; ++ai) {
                v4u zpa[4], zma[4];
#pragma unroll
                for (int m = 0; m < 4; ++m) { const int k = k0 + ai * 128 + m * 16;
                    zpa[m] = *(const v4u*)(P.Z + ((size_t)bb * 4096 + k) * 5888 + 3328 + d0); zma[m] = *(const v4u*)(P.Z + ((size_t)bb * 4096 + ((4096 - k) & 4095)) * 5888 + 3328 + d0); }
                __builtin_amdgcn_sched_barrier(0);
#pragma unroll
                for (int m = 0; m < 4; ++m) { const int k = k0 + ai * 128 + m * 16; const float sg = (k & 1) ? -P.scale : P.scale;
                    bf16* rp = P.Z + ((size_t)bb * 4096 + k) * 5888; bf16* rm = P.Z + ((size_t)bb * 4096 + ((4096 - k) & 4095)) * 5888;
                    const v4u zp = zpa[m], zm = zma[m];
                    float fp[8], fm[8], op[8], om[8];
                    fp[0] = __builtin_bit_cast(float, zp.x << 16); fp[1] = __builtin_bit_cast(float, zp.x & 0xffff0000u); fp[2] = __builtin_bit_cast(float, zp.y << 16); fp[3] = __builtin_bit_cast(float, zp.y & 0xffff0000u);
                    fp[4] = __builtin_bit_cast(float, zp.z << 16); fp[5] = __builtin_bit_cast(float, zp.z & 0xffff0000u); fp[6] = __builtin_bit_cast(float, zp.w << 16); fp[7] = __builtin_bit_cast(float, zp.w & 0xffff0000u);
                    fm[0] = __builtin_bit_cast(float, zm.x << 16); fm[1] = __builtin_bit_cast(float, zm.x & 0xffff0000u); fm[2] = __builtin_bit_cast(float, zm.y << 16); fm[3] = __builtin_bit_cast(float, zm.y & 0xffff0000u);
                    fm[4] = __builtin_bit_cast(float, zm.z << 16); fm[5] = __builtin_bit_cast(float, zm.z & 0xffff0000u); fm[6] = __builtin_bit_cast(float, zm.w << 16); fm[7] = __builtin_bit_cast(float, zm.w & 0xffff0000u);
#pragma unroll
                    for (int i = 0; i < 8; ++i) { const float ec = tot[ai][m][i >> 2][i & 3] * P.scale + sg * ((i < 4) ? e0[i & 3] : e1[i & 3]); const float es = acc[ai][m][i >> 2][i & 3] * P.scale;
                        op[i] = (ec + es) * fp[i]; om[i] = (ec - es) * fm[i]; }
                    v4u w; w.x = cvt_pk_bf16(op[0], op[1]); w.y = cvt_pk_bf16(op[2], op[3]); w.z = cvt_pk_bf16(op[4], op[5]); w.w = cvt_pk_bf16(op[6], op[7]);
                    *(v4u*)(rp + 2816 + d0) = w;
                    if (k != 0) { v4u x; x.x = cvt_pk_bf16(om[0], om[1]); x.y = cvt_pk_bf16(om[2], om[3]); x.z = cvt_pk_bf16(om[4], om[5]); x.w = cvt_pk_bf16(om[6], om[7]); *(v4u*)(rm + 2816 + d0) = x; }
                    acc[ai][m][0] = (f32x4){0.f, 0.f, 0.f, 0.f}; acc[ai][m][1] = (f32x4){0.f, 0.f, 0.f, 0.f}; }
                __builtin_amdgcn_sched_barrier(0);
            }
        }
        if (!has_next) break;
        cur = nxt; cA = nA; cB = nB; ++ui;
        if (wr == 1) PG8_BAR;
    }
    PG8_WAIT_V(0);
    PG8_BAR;
#undef PG8_SA
#undef PG8_SB
#undef PG8_STAGE
#undef PG8_LDA
#undef PG8_LDB
#undef PG8_MMA
#undef PG8_WAIT_V
#undef PG8_WAIT_L
#undef PG8_BAR
#undef PG8_SCHED
}
__device__ __forceinline__ void gemm_phase_m1x(LAS unsigned char* lds, const M1Prob& P, int G, int c, int npanels) {
    constexpr bool ALIGN_EPI = true, SP2 = true;
    int tid_ = threadIdx.x; asm volatile("" : "+v"(tid_));
    const int tid = tid_, wid = __builtin_amdgcn_readfirstlane(tid >> 6), lane = tid & 63, wr = wid >> 2, wc = wid & 3, fr = lane & 15, fq = lane >> 4;
    constexpr int nt = 512 / BK; struct { unsigned lda, ldb; } PP{5888u * 2u, 512u * 2u};
    unsigned voffA[2], voffB[2];
#pragma unroll
    for (int i = 0; i < 2; ++i) { int R, C; stage_rc(tid * 16 + i * 8192, R, C); const int Rb = (R & ~31) + perm32(R & 31);
        voffA[i] = (unsigned)R * PP.lda + (unsigned)C * 2u; voffB[i] = (unsigned)Rb * PP.ldb + (unsigned)C * 2u; }
    const size_t kstep = (size_t)(BK * 2);
    const size_t hstepA = (size_t)HALF * PP.lda, hstepB = (size_t)HALF * PP.ldb;
    const unsigned ldsw = (unsigned)wid * 1024u;
    const int aoff = lds_byte(wr * 64 + fr, fq * 8), boff = lds_byte(wc * 32 + fr, fq * 8);
#define PG8_SA(b, h) (((b) * 2 + (h)) * HTB)
#define PG8_SB(b, h) ((4 + (b) * 2 + (h)) * HTB)
#define PG8_STAGE(bufoff, gbase, voff) do { _Pragma("unroll") for (int _i = 0; _i < 2; ++_i) \
        __builtin_amdgcn_global_load_lds((const unsigned*)((const char*)(gbase) + (voff)[_i]), (LAS unsigned*)(lds + (bufoff) + ldsw + _i * 8192), 16, 0, 0); } while (0)
#define PG8_LDA(dst, b, h) do { _Pragma("unroll") for (int m = 0; m < 4; ++m) _Pragma("unroll") for (int k = 0; k < 2; ++k) dst[m][k] = *(const LAS bf16x8*)(lds + PG8_SA(b, h) + aoff + m * 2048 + k * 1024); } while (0)
#define PG8_LDB(dst, b, h) do { _Pragma("unroll") for (int n = 0; n < 2; ++n) _Pragma("unroll") for (int k = 0; k < 2; ++k) dst[n][k] = *(const LAS bf16x8*)(lds + PG8_SB(b, h) + boff + n * 2048 + k * 1024); } while (0)
#define PG8_MMA(ai, bj, At, Bt) do { __builtin_amdgcn_s_setprio(1); _Pragma("unroll") for (int m = 0; m < 4; ++m) _Pragma("unroll") for (int n = 0; n < 2; ++n) _Pragma("unroll") for (int k = 0; k < 2; ++k) { \
        acc[ai][bj][m][n] = __builtin_amdgcn_mfma_f32_16x16x32_bf16(Bt[n][k], At[m][k], acc[ai][bj][m][n], 0, 0, 0); } __builtin_amdgcn_s_setprio(0); } while (0)
#define PG8_WAIT_V(n) asm volatile("s_waitcnt vmcnt(" #n ")" ::: "memory")
#define PG8_WAIT_L(n) asm volatile("s_waitcnt lgkmcnt(" #n ")" ::: "memory")
#define PG8_BAR __builtin_amdgcn_s_barrier()
#define PG8_SCHED __builtin_amdgcn_sched_barrier(0)
    typedef f32x4 ACC;
    StaticOrder S; S.init(npanels, 8, G, c);
    Unit cur, nxt; int ui = 0;
    if (!S.next(0, cur)) return;
    ACC acc[2][2][4][2];
#pragma unroll
    for (int a = 0; a < 2; ++a)
#pragma unroll
        for (int b = 0; b < 2; ++b)
#pragma unroll
            for (int m = 0; m < 4; ++m)
#pragma unroll
                for (int n = 0; n < 2; ++n) acc[a][b][m][n] = (ACC){0, 0, 0, 0};
    bf16x8 At[4][2], B0[2][2], B1[2][2];
    const char* cA = P.a_ptr(cur.pm, 0); const char* cB = P.b_ptr256(cur.pn, 0);
    if constexpr (SP2) {
        PG8_STAGE(PG8_SB(0, 0), cB, voffB); PG8_STAGE(PG8_SB(0, 1), cB + hstepB, voffB); PG8_STAGE(PG8_SA(0, 0), cA, voffA); PG8_STAGE(PG8_SA(0, 1), cA + hstepA, voffA);
        if (wr == 1) PG8_BAR;
        PG8_WAIT_V(2); PG8_BAR;
        PG8_STAGE(PG8_SB(1, 0), cB + kstep, voffB); PG8_STAGE(PG8_SA(1, 0), cA + kstep, voffA); PG8_STAGE(PG8_SB(1, 1), cB + hstepB + kstep, voffB);
        PG8_WAIT_V(6); PG8_BAR;
    } else {
        PG8_STAGE(PG8_SB(0, 0), cB, voffB); PG8_STAGE(PG8_SA(0, 0), cA, voffA); PG8_STAGE(PG8_SB(0, 1), cB + hstepB, voffB); PG8_STAGE(PG8_SA(0, 1), cA + hstepA, voffA);
        if (wr == 1) PG8_BAR;
        PG8_WAIT_V(4); PG8_BAR;
        PG8_STAGE(PG8_SB(1, 0), cB + kstep, voffB); PG8_STAGE(PG8_SA(1, 0), cA + kstep, voffA); PG8_STAGE(PG8_SB(1, 1), cB + hstepB + kstep, voffB);
        PG8_WAIT_V(6); PG8_BAR;
    }
    for (;;) {
        const int b = ui & 3;
        bool has_next = true;
        if (b == 3) has_next = S.next((ui >> 2) + 1, nxt); else nxt = cur;
        const int nb = (b + 1) & 3;
        const char* nA = has_next ? P.a_ptr(nxt.pm, nb) : cA; const char* nB = has_next ? P.b_ptr256(nxt.pn, nb) : cB;
#pragma unroll 1
        for (int t = 0; t < nt; t += 2) {
            const bool last = (t == nt - 2);
            const char* a1 = cA + (size_t)(t + 1) * kstep;
            const char* a2 = last ? nA : cA + (size_t)(t + 2) * kstep; const char* b2 = last ? nB : cB + (size_t)(t + 2) * kstep;
            const char* a3 = a2 + kstep; const char* b3 = b2 + kstep;
            if constexpr (SP2) {
            PG8_LDB(B0, 0, 0); PG8_LDB(B1, 0, 1); PG8_SCHED; PG8_LDA(At, 0, 0); PG8_STAGE(PG8_SA(1, 1), a1 + hstepA, voffA);
            PG8_WAIT_V(8); PG8_WAIT_L(0); PG8_BAR; PG8_MMA(0, 0, At, B0); PG8_MMA(0, 1, At, B1); PG8_BAR; PG8_SCHED;
            PG8_LDA(At, 0, 1); PG8_STAGE(PG8_SB(0, 0), b2, voffB); PG8_STAGE(PG8_SB(0, 1), b2 + hstepB, voffB); PG8_STAGE(PG8_SA(0, 0), a2, voffA);
            PG8_WAIT_V(8); PG8_WAIT_L(0); PG8_BAR; PG8_MMA(1, 0, At, B0); PG8_MMA(1, 1, At, B1); PG8_BAR; PG8_SCHED;
            PG8_LDB(B0, 1, 0); PG8_LDB(B1, 1, 1); PG8_SCHED; PG8_LDA(At, 1, 0); PG8_STAGE(PG8_SA(0, 1), a2 + hstepA, voffA);
            PG8_WAIT_V(8); PG8_WAIT_L(0); PG8_BAR; PG8_MMA(0, 0, At, B0); PG8_MMA(0, 1, At, B1); PG8_BAR; PG8_SCHED;
            PG8_LDA(At, 1, 1); PG8_STAGE(PG8_SB(1, 0), b3, voffB); PG8_STAGE(PG8_SB(1, 1), b3 + hstepB, voffB); PG8_STAGE(PG8_SA(1, 0), a3, voffA);
            PG8_WAIT_V(8); PG8_WAIT_L(0); PG8_BAR; PG8_MMA(1, 0, At, B0); PG8_MMA(1, 1, At, B1); PG8_BAR; PG8_SCHED;
            } else {
            PG8_LDB(B0, 0, 0); PG8_SCHED; PG8_LDA(At, 0, 0); PG8_STAGE(PG8_SA(1, 1), a1 + hstepA, voffA);
            PG8_WAIT_L(8); PG8_BAR; PG8_WAIT_L(0); PG8_MMA(0, 0, At, B0); PG8_BAR; PG8_SCHED;
            PG8_LDB(B1, 0, 1); PG8_STAGE(PG8_SB(0, 0), b2, voffB);
            PG8_BAR; PG8_WAIT_L(0); PG8_MMA(0, 1, At, B1); PG8_BAR;
            PG8_LDA(At, 0, 1); PG8_STAGE(PG8_SA(0, 0), a2, voffA);
            PG8_BAR; PG8_WAIT_L(0); PG8_MMA(1, 0, At, B0); PG8_BAR; PG8_SCHED;
            PG8_STAGE(PG8_SB(0, 1), b2 + hstepB, voffB);
            PG8_WAIT_V(6); PG8_BAR; PG8_MMA(1, 1, At, B1); PG8_BAR;
            PG8_LDB(B0, 1, 0); PG8_SCHED; PG8_LDA(At, 1, 0); PG8_STAGE(PG8_SA(0, 1), a2 + hstepA, voffA);
            PG8_WAIT_L(8); PG8_BAR; PG8_WAIT_L(0); PG8_MMA(0, 0, At, B0); PG8_BAR; PG8_SCHED;
            PG8_LDB(B1, 1, 1); PG8_STAGE(PG8_SB(1, 0), b3, voffB);
            PG8_BAR; PG8_WAIT_L(0); PG8_MMA(0, 1, At, B1); PG8_BAR;
            PG8_LDA(At, 1, 1); PG8_STAGE(PG8_SA(1, 0), a3, voffA);
            PG8_BAR; PG8_WAIT_L(0); PG8_MMA(1, 0, At, B0); PG8_BAR; PG8_SCHED;
            PG8_STAGE(PG8_SB(1, 1), b3 + hstepB, voffB);
            PG8_WAIT_V(6); PG8_BAR; PG8_MMA(1, 1, At, B1); PG8_BAR;
            }
        }
        if (wr == 0) PG8_BAR;
        {
            const int row0 = cur.pm * 256 + wr * 64 + fr, col0 = cur.pn * 256 + wc * 32 + 8 * fq;
            const unsigned char* gp = P.G + (size_t)row0 * 8192 + b * 2048 + col0;
#pragma unroll
            for (int ai = 0; ai < 2; ++ai) {
                v2u ga[4][2], gb[4][2];
#pragma unroll
                for (int m = 0; m < 4; ++m)
#pragma unroll
                    for (int bj = 0; bj < 2; ++bj) { const unsigned char* q = gp + (size_t)(ai * 128 + m * 16) * 8192 + bj * 128; ga[m][bj] = *(const v2u*)q; gb[m][bj] = (b < 3) ? *(const v2u*)(q + 2048) : ga[m][bj]; }
                __builtin_amdgcn_sched_barrier(0);
#pragma unroll
                for (int m = 0; m < 4; ++m)
#pragma unroll
                    for (int bj = 0; bj < 2; ++bj) {
                        float f[8];
#pragma unroll
                        for (int i = 0; i < 8; ++i) { const unsigned wa = (i < 4) ? ga[m][bj].x : ga[m][bj].y, wb = (i < 4) ? gb[m][bj].x : gb[m][bj].y;
                            unsigned qa = (wa >> (8 * (i & 3))) & 255u, qb = (wb >> (8 * (i & 3))) & 255u; qa = qa < 1u ? 1u : qa; qb = qb < 1u ? 1u : qb;
                            f[i] = (b < 3) ? (float)qa * __builtin_amdgcn_rcpf((float)qb) : (float)qa * (1.0f / 255.0f); }
#pragma unroll
                        for (int n = 0; n < 2; ++n)
#pragma unroll
                            for (int j = 0; j < 4; ++j) acc[ai][bj][m][n][j] *= f[4 * n + j];
                        if (b == 3) { v4u o; o.x = cvt_pk_bf16(acc[ai][bj][m][0][0], acc[ai][bj][m][0][1]); o.y = cvt_pk_bf16(acc[ai][bj][m][0][2], acc[ai][bj][m][0][3]); o.z = cvt_pk_bf16(acc[ai][bj][m][1][0], acc[ai][bj][m][1][1]); o.w = cvt_pk_bf16(acc[ai][bj][m][1][2], acc[ai][bj][m][1][3]);
                            *(v4u*)(P.T + (size_t)(row0 + ai * 128 + m * 16) * 2048 + col0 + bj * 128) = o;
                            acc[ai][bj][m][0] = (ACC){0, 0, 0, 0}; acc[ai][bj][m][1] = (ACC){0, 0, 0, 0}; }
                    }
                __builtin_amdgcn_sched_barrier(0);
            }
        }
        if (!has_next) break;
        cur = nxt; cA = nA; cB = nB; ++ui;
        if (wr == 1) PG8_BAR;
    }
    PG8_WAIT_V(0);
    if constexpr (!ALIGN_EPI) { if (wr == 0) PG8_BAR; }
    PG8_BAR;
#undef PG8_SA
#undef PG8_SB
#undef PG8_STAGE
#undef PG8_LDA
#undef PG8_LDB
#undef PG8_MMA
#undef PG8_WAIT_V
#undef PG8_WAIT_L
#undef PG8_BAR
#undef PG8_SCHED
}
}

constexpr int DM = 2048, NB = 8, SEQ = 4096, DEPTH = 4, CTXL = 256;
constexpr int MLAT = NB * SEQ, MCTX = NB * CTXL, MROWS = MLAT + MCTX;
constexpr int ZW = 5888, NGATE = 8192, N1 = ZW + NGATE;
constexpr int Z_AU = 0, Z_AV = 512, Z_AZ = 1024, Z_BQ = 1536, Z_BK = 2048, Z_BV = 2176, Z_BZ = 2304, Z_FIN = 2816, Z_FZ = 3328, Z_DQ = 3840, Z_DK = 4352, Z_DV = 4864, Z_DZ = 5376;
constexpr float EPSN = 1e-6f, LOG2E = 1.4426950408889634f;
constexpr float QSCALE_B = 0.125f * LOG2E, QSCALE_D = 0.17677669529663687f * LOG2E;
constexpr int NWAVES = 8, NTHR = 512;
#ifndef I8_LAYERS
#define I8_LAYERS 8
#endif
__host__ __device__ constexpr bool i8_layer(int l) { return ((I8_LAYERS >> l) & 1) != 0; }

constexpr size_t MiB = 1u << 20;
constexpr size_t WS_CTL = 0, CTL_ZERO_BYTES = 1 * MiB;
constexpr size_t WS_MOD = 1 * MiB;
constexpr size_t WS_ROPE = 2 * MiB;
constexpr size_t WS_MT = 3 * MiB;
constexpr size_t WS_DFTC = 4 * MiB;
constexpr size_t WS_WSB = 4 * MiB + 256 * 1024;
constexpr size_t WS_RSTDA = 5 * MiB;
constexpr size_t WS_HC = 8 * MiB;
constexpr size_t WS_WCAT = 24 * MiB;
constexpr size_t WS_WBR = 79 * MiB;
constexpr size_t WS_WOUT = 87 * MiB;
constexpr size_t WS_COS2 = 96 * MiB;
constexpr size_t WS_SIN2 = 104 * MiB;
constexpr size_t WS_NBUF = 160 * MiB;
constexpr size_t WS_Z = 296 * MiB;
constexpr size_t WS_G = 687 * MiB;
constexpr size_t WS_N8 = 959 * MiB;
constexpr size_t WS_END = 1023 * MiB;
static_assert(I8_LAYERS == 0 || I8_LAYERS == 8, "n8 holds latent rows only: int8 gates are wired for the last layer");
constexpr size_t WS_WG8 = 47 * MiB;
constexpr size_t WS_ROWS = 6 * MiB + 256 * 1024;
constexpr int CW_CMAX = 65536;
constexpr size_t UT_CTX_OFF = 64 * MiB;
constexpr size_t FST_OFF = 16 * MiB;
constexpr size_t WS_UCH = 5 * MiB + 512 * 1024;
constexpr int CW_BAR = 4096;
constexpr int CW_CVQ = 16384;

constexpr int LDS_BYTES = 147456;
constexpr int MISC_OFF = LDS_BYTES - 128;

__device__ __forceinline__ unsigned f2bf(float f) { unsigned u = __builtin_bit_cast(unsigned, f); return (u + 0x7fffu + ((u >> 16) & 1u)) >> 16; }
__device__ __forceinline__ unsigned pk2(float lo, float hi) { return f2bf(lo) | (f2bf(hi) << 16); }
__device__ __forceinline__ float bflo(unsigned w) { return __builtin_bit_cast(float, w << 16); }
__device__ __forceinline__ float bfhi(unsigned w) { return __builtin_bit_cast(float, w & 0xffff0000u); }
__device__ __forceinline__ float bf2f(bf16 h) { return __builtin_bit_cast(float, ((unsigned)h) << 16); }
__device__ __forceinline__ void unpack8(const v4u w, float (&f)[8]) { f[0] = bflo(w.x); f[1] = bfhi(w.x); f[2] = bflo(w.y); f[3] = bfhi(w.y); f[4] = bflo(w.z); f[5] = bfhi(w.z); f[6] = bflo(w.w); f[7] = bfhi(w.w); }
__device__ __forceinline__ v4u pack8(const float (&f)[8]) { v4u w; w.x = pg8::cvt_pk_bf16(f[0], f[1]); w.y = pg8::cvt_pk_bf16(f[2], f[3]); w.z = pg8::cvt_pk_bf16(f[4], f[5]); w.w = pg8::cvt_pk_bf16(f[6], f[7]); return w; }
__device__ __forceinline__ float fast_exp2(float x) { return __builtin_amdgcn_exp2f(x); }
__device__ __forceinline__ float fast_rcp(float x) { return __builtin_amdgcn_rcpf(x); }
__device__ __forceinline__ float sigmoidf_(float x) { return fast_rcp(1.0f + fast_exp2(-LOG2E * x)); }
__device__ __forceinline__ float siluf_(float x) { return x * sigmoidf_(x); }
__device__ __forceinline__ float gelu_tanh(float x) { const float u = 0.7978845608028654f * (x + 0.044715f * x * x * x); return x * fast_rcp(1.0f + fast_exp2(-2.0f * LOG2E * u)); }

#define XB_TMO      128
#define XB_XCNT(j)  (256  + 64 * (j))
#define XB_XSUB(j)  (1280 + 64 * (j))
#define XB_XGEN(j)  (2304 + 64 * (j))
#define XB_TOP      3328
#define XB_TOPGEN   3392
#define XCD_BAR_WORDS 3456
#define XB_SPIN_CAP (1u << 18)
__device__ __forceinline__ unsigned xb_ld(unsigned* p)              { return __hip_atomic_load(p, __ATOMIC_RELAXED, __HIP_MEMORY_SCOPE_AGENT); }
__device__ __forceinline__ unsigned xb_add(unsigned* p, unsigned v) { return __hip_atomic_fetch_add(p, v, __ATOMIC_RELAXED, __HIP_MEMORY_SCOPE_AGENT); }
__device__ __forceinline__ unsigned xb_xcc_id() { return (unsigned)__builtin_amdgcn_s_getreg((3 << 11) | 20) & 0xFu; }
#define XB_SPIN(cond, bar) do { unsigned _sp = 0; while (cond) { __builtin_amdgcn_s_sleep(1); \
    if ((++_sp & 255u) == 0u) { if (xb_ld(&(bar)[XB_TMO])) break; if (_sp > XB_SPIN_CAP) { atomicAdd(&(bar)[XB_TMO], 1u); break; } } } } while (0)
struct XcdBarrier { unsigned* bar; unsigned x; volatile LAS unsigned* st; };
__device__ __forceinline__ XcdBarrier xcd_barrier_post(unsigned* bar, volatile LAS unsigned* st) {
    XcdBarrier b; b.bar = bar; b.x = xb_xcc_id(); b.st = st;
    if (threadIdx.x == 0) (void)xb_add(&bar[XB_XCNT(b.x)], 1u);
    return b;
}
__device__ __forceinline__ void xcd_barrier_complete(unsigned* bar, unsigned x, unsigned& nloc, unsigned& nx) {
    const unsigned G = gridDim.x * gridDim.y * gridDim.z;
    unsigned sum, cnt, mine, sp = 0u;
    for (;;) {
        sum = 0u; cnt = 0u; mine = 0u;
#pragma unroll
        for (unsigned j = 0; j < 16; ++j) { const unsigned c = xb_ld(&bar[XB_XCNT(j)]); sum += c; cnt += (c > 0u) ? 1u : 0u; mine = (j == x) ? c : mine; }
        if (sum == G) break;
        __builtin_amdgcn_s_sleep(1);
        if ((++sp & 255u) == 0u) { if (xb_ld(&bar[XB_TMO])) break; if (sp > XB_SPIN_CAP) { atomicAdd(&bar[XB_TMO], 1u); break; } }
    }
    nloc = mine > 0u ? mine : 1u; nx = cnt > 0u ? cnt : 1u;
}
__device__ __forceinline__ void xcd_barrier(const XcdBarrier& b) {
    asm volatile("s_waitcnt vmcnt(0)" ::: "memory");
    __syncthreads();
    if (threadIdx.x == 0) {
        unsigned* bar = b.bar;
        __builtin_amdgcn_s_waitcnt(0);
        unsigned nloc = b.st[0], nx = b.st[1];
        if (nloc == 0u) { xcd_barrier_complete(bar, b.x, nloc, nx); b.st[0] = nloc; b.st[1] = nx; }
        const unsigned old = xb_add(&bar[XB_XSUB(b.x)], 1u);
        const unsigned gen = old / nloc;
        if (old + 1u == (gen + 1u) * nloc) {
            __builtin_amdgcn_fence(__ATOMIC_RELEASE, "agent");
            asm volatile("s_waitcnt vmcnt(0)" ::: "memory");
            const unsigned og = xb_add(&bar[XB_TOP], 1u);
            const unsigned tg = og / nx;
            if (og + 1u == (tg + 1u) * nx) xb_add(&bar[XB_TOPGEN], 1u);
            else XB_SPIN(xb_ld(&bar[XB_TOPGEN]) == tg, bar);
            __builtin_amdgcn_fence(__ATOMIC_ACQUIRE, "agent");
            xb_add(&bar[XB_XGEN(b.x)], 1u);
            asm volatile("s_waitcnt vmcnt(0)" ::: "memory");
        } else {
            XB_SPIN(xb_ld(&bar[XB_XGEN(b.x)]) == gen, bar);
            __builtin_amdgcn_fence(__ATOMIC_ACQUIRE, "agent");
            asm volatile("s_waitcnt vmcnt(0)" ::: "memory");
        }
    }
    __syncthreads();
}

__device__ __forceinline__ float wave_sum(float v) {
#pragma unroll
    for (int o = 1; o < 64; o <<= 1) v += __shfl_xor(v, o);
    return v;
}

struct PlainProb {
    const char* A; const char* B; unsigned lda, ldb; int K;
    __device__ __forceinline__ const char* a_ptr(const pg8::Unit& u) const { return A + (size_t)u.pm * 256 * lda; }
    __device__ __forceinline__ const char* b_ptr(const pg8::Unit& u) const { return B + (size_t)u.pn * 256 * ldb; }
};
struct DftProb {
    const char* A; const char* B; unsigned lda, ldb; int K;
    __device__ __forceinline__ const char* a_ptr(const pg8::Unit& u) const { return A + (size_t)(u.pm & 15) * 256 * lda; }
    __device__ __forceinline__ const char* b_ptr(const pg8::Unit& u) const { return B + ((size_t)(u.pm >> 4) * 512 + (size_t)u.pn * 256) * ldb; }
};
struct DftCtxProb {
    const char* A; const char* B; unsigned lda, ldb; int K;
    __device__ __forceinline__ const char* a_ptr(const pg8::Unit&) const { return A; }
    __device__ __forceinline__ const char* b_ptr(const pg8::Unit& u) const { return B + ((size_t)u.pm * 512 + (size_t)u.pn * 256) * ldb; }
};

struct P2Order { pg8::StaticOrder full, lat; bool last; int G, c, nlat, maxi;
    __device__ __forceinline__ void init(int G_, int c_, bool last_, int nN) { full.init(MROWS / 256, nN, G_, c_); lat.init(MLAT / 256, nN, G_, c_); last = last_; G = G_; c = c_; nlat = (MLAT / 256) * nN; maxi = 1 << 30; }
    __device__ __forceinline__ bool next(int i, pg8::Unit& u) const {
        if (i >= maxi) return false;
        if (!last) return full.next(i, u);
        if (lat.next(i, u)) return true;
        const int idx = i * G + c - nlat; if (idx >= 40) return false;
        const int t = idx % 5; u.pm = 128 + idx / 5; u.pn = (t == 0) ? 8 : (16 + t); return true; } };

struct CtxDftOrder { int G, c;
    __device__ __forceinline__ bool next(int i, pg8::Unit& u) const {
        if (i != 0) return false;
        int idx;
        if (G >= 160) { if (c >= 136 && c < 144) idx = c - 136; else if (c >= 152 && c < 160) idx = 8 + c - 152; else return false; }
        else { if (c >= 16) return false; idx = c; }
        u.pm = idx >> 1; u.pn = idx & 1; return true; } };

typedef const f32x4 (&AccRef)[2][2][4][2];

struct EpiP2 {
    static constexpr bool PERM = true;
    bf16* Z; unsigned char* G; const float* bqg; const float* bkg; const float* dqg; const float* dkg; const f32x2* rope;
    __device__ __forceinline__ void operator()(AccRef acc, const pg8::Unit& u, int wr, int wc, int fr, int fq) const { run<2>(acc, u.pm * 256, u.pn, wr, wc, fr, fq); }
    template <int NAI>
    __device__ __forceinline__ void run(const f32x4 (&acc)[NAI][2][4][2], int rowbase, int pn, int wr, int wc, int fr, int fq) const {
        const bool isctx = rowbase >= MLAT;
        const int row0 = rowbase + wr * 64 + fr;
        if (pn >= 23) {
            unsigned char* gb = G + (size_t)(pn - 23) * 256 + wc * 32 + 8 * fq;
#pragma unroll
            for (int ai = 0; ai < NAI; ++ai)
#pragma unroll
                for (int m = 0; m < 4; ++m) { const int row = row0 + ai * 128 + m * 16;
#pragma unroll
                    for (int bj = 0; bj < 2; ++bj) { unsigned w0 = 0u, w1 = 0u;
#pragma unroll
                        for (int j = 0; j < 4; ++j) { const unsigned q0 = (unsigned)(sigmoidf_(acc[ai][bj][m][0][j]) * 255.0f + 0.5f), q1 = (unsigned)(sigmoidf_(acc[ai][bj][m][1][j]) * 255.0f + 0.5f);
                            w0 |= q0 << (8 * j); w1 |= q1 << (8 * j); }
                        v2u w; w.x = w0; w.y = w1; *(v2u*)(gb + (size_t)row * NGATE + bj * 128) = w; } }
        } else if (pn >= 6 && pn <= 8) {
            const bool isq = pn < 8, isv = (pn == 8) && (wc >= 2);
            const int colbase = isq ? (Z_BQ + 64 * (4 * (pn - 6) + wc)) : (isv ? (Z_BV + 64 * (wc - 2)) : (Z_BK + 64 * wc));
            const float* gp = isq ? bqg : bkg;
            float gn[2][8];
#pragma unroll
            for (int bj = 0; bj < 2; ++bj)
#pragma unroll
                for (int i = 0; i < 8; ++i) gn[bj][i] = gp[32 * bj + 8 * fq + i];
            const float osc = isq ? QSCALE_B : 1.0f;
            const bool dorope = !isv && !isctx;
            const f32x2* rbase = rope + 8 * (fq & 1);
#pragma unroll
            for (int ai = 0; ai < NAI; ++ai) {
                f32x2 r0[8];
                if (dorope) {
#pragma unroll
                    for (int i = 0; i < 8; ++i) r0[i] = rbase[(((rowbase >> 6) + wr + 2 * ai) & 63) * 16 + i]; }
#pragma unroll
                for (int m = 0; m < 4; ++m) { const int row = row0 + ai * 128 + m * 16;
                    f32x2 r1[8];
                    if (dorope) {
#pragma unroll
                        for (int i = 0; i < 8; ++i) r1[i] = rbase[((fr + 16 * m) & 63) * 16 + i]; }
                    __builtin_amdgcn_sched_barrier(0);
                    float v[2][8];
#pragma unroll
                    for (int bj = 0; bj < 2; ++bj)
#pragma unroll
                        for (int i = 0; i < 8; ++i) v[bj][i] = acc[ai][bj][m][i >> 2][i & 3];
                    if (!isv) {
                        float ss = 0.f;
#pragma unroll
                        for (int bj = 0; bj < 2; ++bj)
#pragma unroll
                            for (int i = 0; i < 8; ++i) ss += v[bj][i] * v[bj][i];
                        ss += __shfl_xor(ss, 16); ss += __shfl_xor(ss, 32);
                        const float rstd = rsqrtf(ss * (1.0f / 64.0f) + EPSN);
#pragma unroll
                        for (int bj = 0; bj < 2; ++bj)
#pragma unroll
                            for (int i = 0; i < 8; ++i) v[bj][i] = v[bj][i] * rstd * gn[bj][i];
                        if (!isctx) {
#pragma unroll
                            for (int bj = 0; bj < 2; ++bj) {
#pragma unroll
                                for (int i = 0; i < 8; ++i) { const f32x2 cs = bj ? r1[i] : r0[i]; const float partner = __shfl_xor(v[bj][i], 32);
                                    v[bj][i] = (fq & 2) ? (v[bj][i] * cs.x + partner * cs.y) : (v[bj][i] * cs.x - partner * cs.y); } }
                        }
#pragma unroll
                        for (int bj = 0; bj < 2; ++bj)
#pragma unroll
                            for (int i = 0; i < 8; ++i) v[bj][i] *= osc;
                    }
#pragma unroll
                    for (int bj = 0; bj < 2; ++bj) *(v4u*)(Z + (size_t)row * ZW + colbase + 32 * bj + 8 * fq) = pack8(v[bj]);
                }
            }
        } else if (pn >= 15 && pn <= 18) {
            const bool isq = pn < 17; const float* gp = isq ? dqg : dkg; const float osc = isq ? QSCALE_D : 1.0f;
            float gn[8];
#pragma unroll
            for (int i = 0; i < 8; ++i) gn[i] = gp[8 * fq + i];
#pragma unroll
            for (int ai = 0; ai < NAI; ++ai)
#pragma unroll
                for (int m = 0; m < 4; ++m) { const int row = row0 + ai * 128 + m * 16;
#pragma unroll
                    for (int bj = 0; bj < 2; ++bj) { float v[8]; float ss = 0.f;
#pragma unroll
                        for (int i = 0; i < 8; ++i) { v[i] = acc[ai][bj][m][i >> 2][i & 3]; ss += v[i] * v[i]; }
                        ss += __shfl_xor(ss, 16); ss += __shfl_xor(ss, 32);
                        const float rstd = rsqrtf(ss * (1.0f / 32.0f) + EPSN) * osc;
#pragma unroll
                        for (int i = 0; i < 8; ++i) v[i] = v[i] * rstd * gn[i];
                        *(v4u*)(Z + (size_t)row * ZW + pn * 256 + bj * 128 + wc * 32 + 8 * fq) = pack8(v); } }
        } else {
            const int act = (pn < 4) ? 1 : ((pn == 11 || pn == 12 || pn == 19 || pn == 20) ? 0 : 2);
#pragma unroll
            for (int ai = 0; ai < NAI; ++ai)
#pragma unroll
                for (int m = 0; m < 4; ++m) { const int row = row0 + ai * 128 + m * 16;
#pragma unroll
                    for (int bj = 0; bj < 2; ++bj) { float v[8];
#pragma unroll
                        for (int i = 0; i < 8; ++i) { const float x = acc[ai][bj][m][i >> 2][i & 3]; v[i] = (act == 1) ? gelu_tanh(x) : ((act == 2) ? siluf_(x) : x); }
                        *(v4u*)(Z + (size_t)row * ZW + pn * 256 + bj * 128 + wc * 32 + 8 * fq) = pack8(v); } }
        }
    }
};

struct EpiC2 {
    static constexpr bool PERM = true;
    bf16* Z; int rowbase; float scale;
    __device__ __forceinline__ void operator()(AccRef acc, const pg8::Unit& u, int wr, int wc, int fr, int fq) const {
        const int row0 = rowbase + u.pm * 256 + wr * 64 + fr;
#pragma unroll
        for (int ai = 0; ai < 2; ++ai) {
            v4u gz[4][2];
#pragma unroll
            for (int m = 0; m < 4; ++m)
#pragma unroll
                for (int bj = 0; bj < 2; ++bj) gz[m][bj] = *(const v4u*)(Z + (size_t)(row0 + ai * 128 + m * 16) * ZW + Z_FZ + u.pn * 256 + bj * 128 + wc * 32 + 8 * fq);
            __builtin_amdgcn_sched_barrier(0);
#pragma unroll
            for (int m = 0; m < 4; ++m) { const int row = row0 + ai * 128 + m * 16;
#pragma unroll
                for (int bj = 0; bj < 2; ++bj) { const int d = u.pn * 256 + bj * 128 + wc * 32 + 8 * fq;
                    float g[8], v[8]; unpack8(gz[m][bj], g);
#pragma unroll
                    for (int i = 0; i < 8; ++i) v[i] = acc[ai][bj][m][i >> 2][i & 3] * scale * g[i];
                    *(v4u*)(Z + (size_t)row * ZW + Z_FIN + d) = pack8(v); } }
            __builtin_amdgcn_sched_barrier(0);
        }
    }
};

struct EpiM1 {
    static constexpr bool PERM = true;
    bf16* T; const unsigned char* G; int b;
    __device__ __forceinline__ void operator()(AccRef acc, const pg8::Unit& u, int wr, int wc, int fr, int fq) const {
        const int row0 = u.pm * 256 + wr * 64 + fr;
#pragma unroll
        for (int ai = 0; ai < 2; ++ai)
#pragma unroll
            for (int m = 0; m < 4; ++m) { const int row = row0 + ai * 128 + m * 16;
#pragma unroll
                for (int bj = 0; bj < 2; ++bj) { const int col = u.pn * 256 + bj * 128 + wc * 32 + 8 * fq;
                    const v2u gq = *(const v2u*)(G + (size_t)row * NGATE + b * 2048 + col);
                    float v[8];
#pragma unroll
                    for (int i = 0; i < 8; ++i) { const unsigned w = (i < 4) ? gq.x : gq.y; const float g = (float)((w >> (8 * (i & 3))) & 255u) * (1.0f / 255.0f); v[i] = acc[ai][bj][m][i >> 2][i & 3] * g; }
                    bf16* tp = T + (size_t)row * DM + col;
                    if (b > 0) { float o[8]; unpack8(*(const v4u*)tp, o);
#pragma unroll
                        for (int i = 0; i < 8; ++i) v[i] += o[i]; }
                    *(v4u*)tp = pack8(v); } }
    }
};

struct EpiM2 {
    static constexpr bool PERM = false;
    const float* hin_lat; float* hout_lat; const float* hin_ctx; float* hout_ctx; const float* mod; const unsigned* flag;
    __device__ __forceinline__ void operator()(AccRef acc, const pg8::Unit& u, int wr, int wc, int fr, int fq) const {
        const int row0 = u.pm * 256 + wr * 64 + fr; const bool isctx = u.pm >= 128;
        const int bi = isctx ? 8 : (row0 >> 12);
        const float* hi0 = isctx ? hin_ctx + (size_t)(row0 - MLAT) * DM : hin_lat + (size_t)row0 * DM;
        float* ho0 = isctx ? hout_ctx + (size_t)(row0 - MLAT) * DM : hout_lat + (size_t)row0 * DM;
        const int colb = u.pn * 256 + wc * 32 + 4 * fq;
        const float* gt = mod + bi * 6144 + 4096 + colb;
        f32x4 g[2][2];
#pragma unroll
        for (int bj = 0; bj < 2; ++bj)
#pragma unroll
            for (int n = 0; n < 2; ++n) g[bj][n] = *(const f32x4*)(gt + bj * 128 + 16 * n);
#pragma unroll
        for (int ai = 0; ai < 2; ++ai) {
            f32x4 h[4][2][2];
#pragma unroll
            for (int m = 0; m < 4; ++m)
#pragma unroll
                for (int bj = 0; bj < 2; ++bj)
#pragma unroll
                    for (int n = 0; n < 2; ++n) h[m][bj][n] = *(const f32x4*)(hi0 + (size_t)(ai * 128 + m * 16) * DM + colb + bj * 128 + 16 * n);
            __builtin_amdgcn_sched_barrier(0);
#pragma unroll
            for (int m = 0; m < 4; ++m)
#pragma unroll
                for (int bj = 0; bj < 2; ++bj)
#pragma unroll
                    for (int n = 0; n < 2; ++n) *(f32x4*)(ho0 + (size_t)(ai * 128 + m * 16) * DM + colb + bj * 128 + 16 * n) = h[m][bj][n] + g[bj][n] * acc[ai][bj][m][n];
            __builtin_amdgcn_sched_barrier(0);
        }
        if (flag && u.pm == 0 && u.pn == 0 && wr == 0 && wc == 0 && fr == 0 && fq == 0 && *flag != 0u) { asm volatile("s_waitcnt vmcnt(0)" ::: "memory"); hout_lat[0] = __builtin_nanf(""); }
    }
};

struct QuarterOrder { int G, c;
    __device__ __forceinline__ bool next(int i, pg8::Unit& u) const { const int q = i * G + c; if (q >= 256) return false; u.pm = q >> 2; u.pn = q & 3; return true; } };
struct M2CtxProb {
    const char* A; const char* B; unsigned lda, ldb; int K;
    __device__ __forceinline__ const char* a_ptr(const pg8::Unit& u) const { return A + (size_t)(128 + (u.pm >> 3)) * 256 * lda + (size_t)u.pn * 512 * 2; }
    __device__ __forceinline__ const char* b_ptr(const pg8::Unit& u) const { return B + (size_t)(u.pm & 7) * 256 * ldb + (size_t)u.pn * 512 * 2; }
};
struct EpiM2Ctx {
    static constexpr bool PERM = false;
    float* hc; const float* mod;
    __device__ __forceinline__ void operator()(AccRef acc, const pg8::Unit& u, int wr, int wc, int fr, int fq) const {
        const int row0 = (u.pm >> 3) * 256 + wr * 64 + fr, colb = (u.pm & 7) * 256 + wc * 32 + 4 * fq;
        const float* gt = mod + 8 * 6144 + 4096;
#pragma unroll
        for (int ai = 0; ai < 2; ++ai)
#pragma unroll
            for (int m = 0; m < 4; ++m) { float* ho = hc + (size_t)(row0 + ai * 128 + m * 16) * DM;
#pragma unroll
                for (int bj = 0; bj < 2; ++bj)
#pragma unroll
                    for (int n = 0; n < 2; ++n) { const int col = colb + bj * 128 + 16 * n; const f32x4 g = *(const f32x4*)(gt + col);
#pragma unroll
                        for (int j = 0; j < 4; ++j) unsafeAtomicAdd(ho + col + j, g[j] * acc[ai][bj][m][n][j]); } }
    }
};

struct EpiNull {
    static constexpr bool PERM = true;
    __device__ __forceinline__ void operator()(AccRef acc, const pg8::Unit& u, int wr, int wc, int fr, int fq) const {
#pragma unroll
        for (int ai = 0; ai < 2; ++ai)
#pragma unroll
            for (int bj = 0; bj < 2; ++bj)
#pragma unroll
                for (int m = 0; m < 4; ++m)
#pragma unroll
                    for (int n = 0; n < 2; ++n) asm volatile("" :: "v"(acc[ai][bj][m][n][0]), "v"(acc[ai][bj][m][n][1]), "v"(acc[ai][bj][m][n][2]), "v"(acc[ai][bj][m][n][3]));
    }
};

struct EpiGate {
    static constexpr bool PERM = true;
    unsigned char* G; const float* rows; const unsigned* cmax;
    __device__ __forceinline__ void operator()(const pg8::i32x4 (&acc)[2][2][4][2], const pg8::Unit& u, int wr, int wc, int fr, int fq) const {
        const int row0 = u.pm * 256 + wr * 64 + fr, col0 = u.pn * 256 + wc * 32 + 8 * fq;
        float cs[2][8];
#pragma unroll
        for (int bj = 0; bj < 2; ++bj) { const v4u a = *(const v4u*)(cmax + col0 + bj * 128), b = *(const v4u*)(cmax + col0 + bj * 128 + 4);
            cs[bj][0] = __builtin_bit_cast(float, a.x); cs[bj][1] = __builtin_bit_cast(float, a.y); cs[bj][2] = __builtin_bit_cast(float, a.z); cs[bj][3] = __builtin_bit_cast(float, a.w);
            cs[bj][4] = __builtin_bit_cast(float, b.x); cs[bj][5] = __builtin_bit_cast(float, b.y); cs[bj][6] = __builtin_bit_cast(float, b.z); cs[bj][7] = __builtin_bit_cast(float, b.w); }
        float rsv[2][4];
#pragma unroll
        for (int ai = 0; ai < 2; ++ai)
#pragma unroll
            for (int m = 0; m < 4; ++m) rsv[ai][m] = rows[row0 + ai * 128 + m * 16];
        __builtin_amdgcn_sched_barrier(0);
#pragma unroll
        for (int ai = 0; ai < 2; ++ai)
#pragma unroll
            for (int m = 0; m < 4; ++m) { const int row = row0 + ai * 128 + m * 16; const float rs = rsv[ai][m] * (-LOG2E / 127.0f);
#pragma unroll
                for (int bj = 0; bj < 2; ++bj) { unsigned w0 = 0u, w1 = 0u;
#pragma unroll
                    for (int j = 0; j < 4; ++j) {
                        const float x0 = (float)acc[ai][bj][m][0][j] * (rs * cs[bj][j]), x1 = (float)acc[ai][bj][m][1][j] * (rs * cs[bj][4 + j]);
                        const unsigned q0 = (unsigned)(fast_rcp(1.0f + fast_exp2(x0)) * 255.0f + 0.5f), q1 = (unsigned)(fast_rcp(1.0f + fast_exp2(x1)) * 255.0f + 0.5f);
                        w0 |= q0 << (8 * j); w1 |= q1 << (8 * j); }
                    v2u w; w.x = w0; w.y = w1; *(v2u*)(G + (size_t)row * NGATE + col0 + bj * 128) = w; } }
    }
};

struct Args { const float* in[21]; float* out; unsigned char* ws; int ph_lo, ph_hi; };
enum { I_X = 0, I_C, I_CTX, I_CCTX, I_NORMG, I_WADA, I_BADA, I_WIN, I_ANG, I_AWS, I_ABS, I_BQG, I_BKG, I_BSINK, I_CWF, I_DQG, I_DKG, I_RPB, I_WGATE, I_WBR, I_WOUT };

struct Frame {
    LAS unsigned char* lds; int tid, lane, wave, G, gw, NGW, gtid, NT;
};
__device__ __forceinline__ Frame make_frame(LAS unsigned char* lds) {
    Frame F; int t = threadIdx.x; asm volatile("" : "+v"(t));
    F.lds = lds; F.tid = t; F.lane = t & 63; F.wave = __builtin_amdgcn_readfirstlane(t >> 6);
    F.G = gridDim.x; F.gw = blockIdx.x * NWAVES + F.wave; F.NGW = F.G * NWAVES; F.gtid = blockIdx.x * NTHR + t; F.NT = F.G * NTHR;
    return F;
}

__device__ __forceinline__ void build_costab(Frame& F) {
    LAS float* T = (LAS float*)F.lds;
    for (int t = F.tid; t < 4096; t += NTHR) T[t] = cospif((float)t * (1.0f / 2048.0f));
    __syncthreads();
}
__device__ __forceinline__ void pro_mod(Frame& F, const float* c, const float* cctx, const float* wada, const float* bada, const float* normg, float* mod) {
    LAS float* sc = (LAS float*)(F.lds + 16384);
    LAS float* red = (LAS float*)(F.lds + 16384 + 73728);
    for (int i = F.tid; i < 9 * 2048; i += NTHR) { const float x = (i < 8 * 2048) ? c[i] : cctx[i - 8 * 2048]; sc[i] = x / (1.0f + expf(-x)); }
    __syncthreads();
    const int kg = F.tid >> 7, cl = F.tid & 127;
    for (int item = blockIdx.x; item < DEPTH * 48; item += F.G) {
        const int l = item / 48, j = (item % 48) * 128 + cl;
        const float* wp = wada + (size_t)l * 2048 * 6144 + (size_t)(kg * 512) * 6144 + j;
        float a[9];
#pragma unroll
        for (int b = 0; b < 9; ++b) a[b] = 0.f;
#pragma unroll 1
        for (int k0 = 0; k0 < 512; k0 += 16) {
            float w[16];
#pragma unroll
            for (int i = 0; i < 16; ++i) w[i] = wp[(size_t)(k0 + i) * 6144];
            __builtin_amdgcn_sched_barrier(0);
#pragma unroll
            for (int i = 0; i < 16; ++i)
#pragma unroll
                for (int b = 0; b < 9; ++b) a[b] += sc[b * 2048 + kg * 512 + k0 + i] * w[i]; }
#pragma unroll
        for (int b = 0; b < 9; ++b) red[(kg * 9 + b) * 128 + cl] = a[b];
        __syncthreads();
        for (int i = F.tid; i < 9 * 128; i += NTHR) { const int b = i >> 7, cc = i & 127; const int jj = (item % 48) * 128 + cc;
            float mv = ((red[(0 * 9 + b) * 128 + cc] + red[(1 * 9 + b) * 128 + cc]) + (red[(2 * 9 + b) * 128 + cc] + red[(3 * 9 + b) * 128 + cc])) + bada[l * 6144 + jj];
            if (jj >= 2048 && jj < 4096) mv = (1.0f + mv) * normg[l * DM + jj - 2048];
            mod[((size_t)l * 9 + b) * 6144 + jj] = mv; }
        __syncthreads();
    }
}
__device__ __forceinline__ void pro_colmax(Frame& F, const float* wgate, unsigned* cmax) {
    for (int item = blockIdx.x; item < DEPTH * 4 * 16 * 4; item += F.G) {
        const int cg = item & 3, kc = (item >> 2) & 15, lb = item >> 6;
        if (!i8_layer(lb >> 2)) continue;
        const float* wp = wgate + ((size_t)lb * DM + kc * 128) * DM + cg * 512 + F.tid; float mx = 0.f;
#pragma unroll 1
        for (int k0 = 0; k0 < 128; k0 += 16) { float w[16];
#pragma unroll
            for (int i = 0; i < 16; ++i) w[i] = wp[(size_t)(k0 + i) * DM];
            __builtin_amdgcn_sched_barrier(0);
#pragma unroll
            for (int i = 0; i < 16; ++i) mx = fmaxf(mx, fabsf(w[i])); }
        atomicMax(cmax + (size_t)lb * DM + cg * 512 + F.tid, __builtin_bit_cast(unsigned, mx));
    }
}
__device__ __forceinline__ void pro_tables(Frame& F, const float* cwf, bf16* cos2, bf16* sin2, bf16* dftc, f32x2* rope, bf16* mt, const float* aws, bf16* wsb) {
    const LAS float* T = (const LAS float*)F.lds;
    for (int it = F.gtid; it < DEPTH * 4 * 128 * 128; it += F.NT) wsb[it] = (bf16)f2bf(aws[it]);
    for (int it = F.gtid; it < 2 * 2048 * 256; it += F.NT) { const int part = it >> 19, r = it & ((1 << 19) - 1), k = r >> 8, l0 = (r & 255) * 8;
        float v[8];
#pragma unroll
        for (int i = 0; i < 8; ++i) { const int idx = (k * (l0 + i)) & 4095; v[i] = T[part ? ((idx - 1024) & 4095) : idx]; }
        *(v4u*)((part ? sin2 : cos2) + (size_t)k * 2048 + l0) = pack8(v); }
    for (int it = F.gtid; it < 256 * 64; it += F.NT) { const int k = it >> 6, c0 = (it & 63) * 8; const int part = c0 >> 8, l0 = c0 & 255;
        float v[8];
#pragma unroll
        for (int i = 0; i < 8; ++i) { const int idx = ((k * (l0 + i)) & 255) * 16; v[i] = T[part ? ((idx - 1024) & 4095) : idx]; }
        *(v4u*)(dftc + (size_t)k * 512 + c0) = pack8(v); }
    for (int it = F.gtid; it < 1024; it += F.NT) { const int p = it >> 4, i = it & 15; const float inv = powf(10000.0f, -(float)i * (1.0f / 16.0f)); const float ang = (float)p * inv;
        f32x2 cs; cs.x = cosf(ang); cs.y = sinf(ang); rope[it] = cs; }
    for (int it = F.gtid; it < DEPTH * 4 * 2 * 128 * 128; it += F.NT) { const int c = it & 127, d = (it >> 7) & 127, part = (it >> 14) & 1, lg = it >> 15;
        const float* wf = cwf + (size_t)lg * 128 * 128 + d; float s = 0.f;
        for (int m = 0; m < 128; ++m) { const int idx = ((m * c) & 127) * 32; s += T[part ? ((idx - 1024) & 4095) : idx] * wf[m * 128]; }
        mt[it] = (bf16)f2bf(part ? -s : s); }
}

__device__ __forceinline__ void transpose_item(const float* W, int N, int k0, int n0, bf16* WT, int K, int drow0, LAS float* scr, int lane) {
    float tmp[32];
    const float* wp = W + (size_t)(k0 + (lane >> 5)) * N + n0 + (lane & 31);
#pragma unroll
    for (int i = 0; i < 32; ++i) tmp[i] = wp[(size_t)(2 * i) * N];
#pragma unroll
    for (int i = 0; i < 32; ++i) { const int kk = 2 * i + (lane >> 5); scr[kk * 33 + (lane & 31)] = tmp[i]; }
    asm volatile("s_waitcnt lgkmcnt(0)" ::: "memory");
    const int c = lane & 7;
#pragma unroll
    for (int j = 0; j < 4; ++j) { const int n = (lane >> 3) + 8 * j; const LAS float* s = scr + (8 * c) * 33 + n;
        v4u o; o.x = pk2(s[0 * 33], s[1 * 33]); o.y = pk2(s[2 * 33], s[3 * 33]); o.z = pk2(s[4 * 33], s[5 * 33]); o.w = pk2(s[6 * 33], s[7 * 33]);
        *(v4u*)(WT + (size_t)(drow0 + n) * K + k0 + 8 * c) = o; }
    asm volatile("s_waitcnt lgkmcnt(0)" ::: "memory");
}
__device__ __forceinline__ void quant_item(const float* W, int N, int k0, int n0, signed char* WT, int drow0, const unsigned* cmax, LAS float* scr, int lane) {
    float tmp[32];
    const float* wp = W + (size_t)(k0 + (lane >> 5)) * N + n0 + (lane & 31);
#pragma unroll
    for (int i = 0; i < 32; ++i) tmp[i] = wp[(size_t)(2 * i) * N];
#pragma unroll
    for (int i = 0; i < 32; ++i) { const int kk = 2 * i + (lane >> 5); scr[kk * 33 + (lane & 31)] = tmp[i]; }
    asm volatile("s_waitcnt lgkmcnt(0)" ::: "memory");
    const int n = lane >> 1, kh = lane & 1;
    const float am = __builtin_bit_cast(float, cmax[n0 + n]); const float inv = am > 0.f ? 127.0f / am : 0.f;
    unsigned w[8];
#pragma unroll
    for (int d = 0; d < 8; ++d) { unsigned acc = 0u;
#pragma unroll
        for (int e = 0; e < 4; ++e) { const int q = (int)rintf(scr[(32 * kh + 4 * d + e) * 33 + n] * inv); acc |= ((unsigned)q & 255u) << (8 * e); }
        w[d] = acc; }
    signed char* dst = WT + (size_t)(drow0 + n) * DM + k0 + 32 * kh;
    v4u o0; o0.x = w[0]; o0.y = w[1]; o0.z = w[2]; o0.w = w[3]; v4u o1; o1.x = w[4]; o1.y = w[5]; o1.z = w[6]; o1.w = w[7];
    *(v4u*)dst = o0; *(v4u*)(dst + 16) = o1;
    asm volatile("s_waitcnt lgkmcnt(0)" ::: "memory");
}
__device__ __forceinline__ int win_dest_row(int n0) {
    if (n0 >= Z_BQ && n0 < Z_BK) { const int j = n0 - Z_BQ, H = j >> 6, s = (j >> 5) & 1; return Z_BQ + 256 * (H >> 2) + 128 * s + 32 * (H & 3); }
    if (n0 >= Z_BK && n0 < Z_BV) { const int j = n0 - Z_BK, h = j >> 6, s = (j >> 5) & 1; return Z_BK + 128 * s + 32 * h; }
    if (n0 >= Z_BV && n0 < Z_BZ) { const int j = n0 - Z_BV, h = j >> 6, s = (j >> 5) & 1; return Z_BK + 128 * s + 32 * (h + 2); }
    return n0;
}
constexpr int CV_IN = 32 * (ZW / 32), CV_GT = 4 * 32 * 64, CV_BR = 4 * 8 * 64, CV_OUT = 32 * 64, CV_ALL = CV_IN + CV_GT + CV_BR + CV_OUT;
__device__ __forceinline__ void convert_item(const Args& a, int l, int it, LAS float* scr, int lane) {
    unsigned char* ws = a.ws;
    bf16* wcat = (bf16*)(ws + WS_WCAT); bf16* wbr = (bf16*)(ws + WS_WBR); bf16* wout = (bf16*)(ws + WS_WOUT);
    int r = it;
    if (r < CV_IN) { const float* win = a.in[I_WIN] + (size_t)l * DM * ZW; const int nb = r % (ZW / 32), kb = r / (ZW / 32); transpose_item(win, ZW, kb * 64, nb * 32, wcat, DM, win_dest_row(nb * 32), scr, lane); return; } r -= CV_IN;
    if (r < CV_GT) { const float* wgate = a.in[I_WGATE] + (size_t)l * 4 * DM * DM; const int b = r / 2048, q = r % 2048, nb = q % 64, kb = q / 64;
        if (!i8_layer(l)) { transpose_item(wgate + (size_t)b * DM * DM, DM, kb * 64, nb * 32, wcat, DM, ZW + b * 2048 + nb * 32, scr, lane); return; }
        quant_item(wgate + (size_t)b * DM * DM, DM, kb * 64, nb * 32, (signed char*)(ws + WS_WG8), b * 2048 + nb * 32, (const unsigned*)(ws + WS_CTL) + CW_CMAX + (size_t)l * 8192 + b * 2048, scr, lane); return; } r -= CV_GT;
    if (r < CV_BR) { const float* wbrs = a.in[I_WBR] + (size_t)l * 4 * 512 * DM; const int b = r / 512, q = r % 512, nb = q % 64, kb = q / 64; transpose_item(wbrs + (size_t)b * 512 * DM, DM, kb * 64, nb * 32, wbr + (size_t)b * DM * 512, 512, nb * 32, scr, lane); return; } r -= CV_BR;
    { const float* wouts = a.in[I_WOUT] + (size_t)l * DM * DM; const int nb = r % 64, kb = r / 64; transpose_item(wouts, DM, kb * 64, nb * 32, wout, DM, nb * 32, scr, lane); }
}
__device__ __forceinline__ void phase_convert(LAS unsigned char* lds_, const Args& a, int l, int it_lo, int it_hi, unsigned* ctr, int max_grabs = 1 << 30) {
    Frame F = make_frame(lds_);
    LAS float* scr = (LAS float*)(F.lds + F.wave * 16384);
    if (!ctr) { for (int it = it_lo + F.gw; it < it_hi; it += F.NGW) convert_item(a, l, it, scr, F.lane); }
    else {
        for (int gcount = 0; gcount < max_grabs; ++gcount) {
            unsigned base = 0u; if (F.lane == 0) base = __hip_atomic_fetch_add(ctr, 4u, __ATOMIC_RELAXED, __HIP_MEMORY_SCOPE_AGENT);
            const int i0 = it_lo + (int)__builtin_amdgcn_readfirstlane(base);
            if (i0 >= it_hi) break;
#pragma unroll 1
            for (int k = 0; k < 4; ++k) if (i0 + k < it_hi) convert_item(a, l, i0 + k, scr, F.lane);
        }
    }
}
__device__ __forceinline__ void phase_hc_init(LAS unsigned char* lds_, const Args& a) {
    Frame F = make_frame(lds_);
    for (int i = F.gtid; i < MCTX * DM / 4; i += F.NT) ((f32x4*)(a.ws + WS_HC))[i] = ((const f32x4*)a.in[I_CTX])[i];
}
__device__ __forceinline__ void phase_norm(LAS unsigned char* lds_, const Args& a, int l) {
    Frame F = make_frame(lds_);
    unsigned char* ws = a.ws;
    const float* hl = l ? a.out : a.in[I_X]; const float* hc = l ? (const float*)(ws + WS_HC) : a.in[I_CTX];
    const float* mod = (const float*)(ws + WS_MOD) + (size_t)l * 9 * 6144;
    bf16* nbuf = (bf16*)(ws + WS_NBUF); signed char* n8 = (signed char*)(ws + WS_N8); float* rowsc = (float*)(ws + WS_ROWS);
    f32x4 vn[8];
    { const int row = F.gw; if (row < MROWS) { const float* hr = row >= MLAT ? hc + (size_t)(row - MLAT) * DM : hl + (size_t)row * DM;
#pragma unroll
        for (int j = 0; j < 8; ++j) vn[j] = *(const f32x4*)(hr + j * 256 + F.lane * 4); } }
    for (int row = F.gw; row < MROWS; row += F.NGW) {
        const bool isctx = row >= MLAT; const int bi = isctx ? 8 : (row >> 12);
        const float* sh = mod + bi * 6144; const float* scp = sh + 2048;
        f32x4 v[8]; float ss = 0.f;
#pragma unroll
        for (int j = 0; j < 8; ++j) v[j] = vn[j];
        f32x4 pa[8], ps[8];
#pragma unroll
        for (int j = 0; j < 8; ++j) { const int c = j * 256 + F.lane * 4; pa[j] = *(const f32x4*)(scp + c); ps[j] = *(const f32x4*)(sh + c); }
        __builtin_amdgcn_sched_barrier(0);
        { int nrow = row + F.NGW; nrow = nrow < MROWS ? nrow : row;
            const float* hr = nrow >= MLAT ? hc + (size_t)(nrow - MLAT) * DM : hl + (size_t)nrow * DM;
#pragma unroll
            for (int j = 0; j < 8; ++j) vn[j] = *(const f32x4*)(hr + j * 256 + F.lane * 4); }
        __builtin_amdgcn_sched_barrier(0);
#pragma unroll
        for (int j = 0; j < 8; ++j) ss += (v[j].x * v[j].x + v[j].y * v[j].y) + (v[j].z * v[j].z + v[j].w * v[j].w);
        const float rstd = rsqrtf(wave_sum(ss) * (1.0f / DM) + EPSN);
#pragma unroll
        for (int j = 0; j < 8; ++j) { const int c = j * 256 + F.lane * 4;
            const f32x4 o = v[j] * rstd * pa[j] + ps[j]; v[j] = o;
            v2u w; w.x = pk2(o.x, o.y); w.y = pk2(o.z, o.w); *(v2u*)(nbuf + (size_t)row * DM + c) = w; }
        if (!i8_layer(l) || row >= MLAT) continue;
        float am = 0.f;
#pragma unroll
        for (int j = 0; j < 8; ++j) am = fmaxf(am, fmaxf(fmaxf(fabsf(v[j].x), fabsf(v[j].y)), fmaxf(fabsf(v[j].z), fabsf(v[j].w))));
#pragma unroll
        for (int o_ = 1; o_ < 64; o_ <<= 1) am = fmaxf(am, __shfl_xor(am, o_));
        const float inv = am > 0.f ? 127.0f / am : 0.f;
        if (F.lane == 0) rowsc[row] = am * (1.0f / 127.0f);
#pragma unroll
        for (int j = 0; j < 8; ++j) { const int q0 = (int)rintf(v[j].x * inv), q1 = (int)rintf(v[j].y * inv), q2 = (int)rintf(v[j].z * inv), q3 = (int)rintf(v[j].w * inv);
            *(unsigned*)(n8 + (size_t)row * DM + j * 256 + F.lane * 4) = ((unsigned)q0 & 255u) | (((unsigned)q1 & 255u) << 8) | (((unsigned)q2 & 255u) << 16) | (((unsigned)q3 & 255u) << 24); }
    }
}

__device__ __forceinline__ void phase_x1(LAS unsigned char* lds_, const Args& a, int l, bool last) {
    Frame F = make_frame(lds_);
    unsigned char* ws = a.ws; const bf16* Z = (const bf16*)(ws + WS_Z); float* rstda = (float*)(ws + WS_RSTDA);
    const int nrows = last ? MLAT : MROWS;
#pragma unroll 1
    for (int row0 = F.gw; row0 < nrows; row0 += 6 * F.NGW) {
        v4u t[6];
#pragma unroll
        for (int j = 0; j < 6; ++j) { const int row = row0 + j * F.NGW; t[j] = (v4u){0u, 0u, 0u, 0u}; if (row < nrows) t[j] = *(const v4u*)(Z + (size_t)row * ZW + Z_AV + F.lane * 8); }
        __builtin_amdgcn_sched_barrier(0);
#pragma unroll
        for (int j = 0; j < 6; ++j) { const int row = row0 + j * F.NGW; float f[8]; unpack8(t[j], f); float ss = 0.f;
#pragma unroll
            for (int i = 0; i < 8; ++i) ss += f[i] * f[i];
            ss = wave_sum(ss);
            if (F.lane == 0 && row < nrows) rstda[row] = rsqrtf(ss * (1.0f / 512.0f) + EPSN); }
    }
}

__device__ __forceinline__ void phase_c1_naive(LAS unsigned char* lds_, const Args& a, int l) {
    Frame F = make_frame(lds_);
    unsigned char* ws = a.ws; const bf16* Z = (const bf16*)(ws + WS_Z);
    const bf16* mt = (const bf16*)(ws + WS_MT) + (size_t)l * 4 * 2 * 128 * 128;
    bf16* ut = (bf16*)(ws + WS_NBUF); bf16* utc = (bf16*)(ws + WS_NBUF + UT_CTX_OFF);
    constexpr int NL = NB * 512 * 2 * 64, NC = NB * 512 * 2 * 4;
    for (int it = F.gw; it < NL + NC; it += F.NGW) {
        const bool isctx = it >= NL; const int r = isctx ? it - NL : it;
        const int pg = isctx ? (r & 3) : (r & 63), rest = isctx ? (r >> 2) : (r >> 6), part = rest & 1, d = (rest >> 1) & 511, b = rest >> 10;
        const int pos = pg * 64 + F.lane, g = d >> 7;
        const bf16* xr = Z + (size_t)(isctx ? MLAT + b * CTXL + pos : b * SEQ + pos) * ZW + Z_FIN + g * 128;
        const bf16* mr = mt + ((size_t)(g * 2 + part) * 128 + (d & 127)) * 128;
        float s = 0.f;
#pragma unroll 4
        for (int c8 = 0; c8 < 16; ++c8) { float x[8], w[8]; unpack8(*(const v4u*)(xr + c8 * 8), x); unpack8(*(const v4u*)(mr + c8 * 8), w);
#pragma unroll
            for (int i = 0; i < 8; ++i) s += x[i] * w[i]; }
        if (isctx) utc[((size_t)b * 512 + d) * 512 + part * 256 + pos] = (bf16)f2bf(s);
        else ut[((size_t)b * 512 + d) * 8192 + part * 4096 + pos] = (bf16)f2bf(s);
    }
}

__device__ __forceinline__ void phase_a_naive(LAS unsigned char* lds_, const Args& a, int l) {
    Frame F = make_frame(lds_);
    unsigned char* ws = a.ws; bf16* Z = (bf16*)(ws + WS_Z); const float* rstda = (const float*)(ws + WS_RSTDA);
    const float* wsp = a.in[I_AWS] + (size_t)l * 4 * 128 * 128; const float* bsp = a.in[I_ABS] + l * 4 * 128; const float* gv = a.in[I_ANG] + l * 512;
    for (int it = F.gtid; it < MROWS * 64; it += F.NT) {
        const int cg = it & 63, row = it >> 6, c0 = cg * 8, g = cg >> 4, t = row & 127, chunk0 = row & ~127;
        const float* wr_ = wsp + ((size_t)g * 128 + t) * 128;
        float mix[8];
#pragma unroll
        for (int i = 0; i < 8; ++i) mix[i] = 0.f;
        for (int s = 0; s < 128; ++s) { float x[8]; unpack8(*(const v4u*)(Z + (size_t)(chunk0 + s) * ZW + Z_AV + c0), x); const float w = wr_[s] * rstda[chunk0 + s];
#pragma unroll
            for (int i = 0; i < 8; ++i) mix[i] += w * x[i]; }
        float u[8], zz[8], o[8]; unpack8(*(const v4u*)(Z + (size_t)row * ZW + Z_AU + c0), u); unpack8(*(const v4u*)(Z + (size_t)row * ZW + Z_AZ + c0), zz);
        const float bias = bsp[g * 128 + t];
#pragma unroll
        for (int i = 0; i < 8; ++i) o[i] = u[i] * (mix[i] * gv[c0 + i] + bias) * zz[i];
        *(v4u*)(Z + (size_t)row * ZW + Z_AU + c0) = pack8(o);
    }
}

__device__ __forceinline__ void phase_b_naive(LAS unsigned char* lds_, const Args& a, int l) {
    Frame F = make_frame(lds_);
    unsigned char* ws = a.ws; bf16* Z = (bf16*)(ws + WS_Z); const float* sink = a.in[I_BSINK] + l * 8;
    for (int it = F.gtid; it < MROWS * 8; it += F.NT) {
        const int H = it / MROWS, row = it - H * MROWS, kh = H >> 2; const bool isctx = row >= MLAT;
        const int b = isctx ? ((row - MLAT) >> 8) : (row >> 12), pos = row & 4095;
        const int k0 = isctx ? 0 : (pos > 128 ? pos - 128 : 0), k1 = isctx ? -1 : (pos + 128 < SEQ ? pos + 128 : SEQ - 1), nloc = k1 - k0 + 1;
        float q[64], o[64];
#pragma unroll
        for (int c8 = 0; c8 < 8; ++c8) { float t8[8]; unpack8(*(const v4u*)(Z + (size_t)row * ZW + Z_BQ + H * 64 + c8 * 8), t8);
#pragma unroll
            for (int i = 0; i < 8; ++i) { q[c8 * 8 + i] = t8[i]; o[c8 * 8 + i] = 0.f; } }
        float mx = -1e30f, den = 0.f;
        for (int t = 0; t < nloc + CTXL; ++t) {
            const size_t krow = (t < nloc) ? (size_t)(b * SEQ + k0 + t) : (size_t)(MLAT + b * CTXL + (t - nloc));
            const bf16* kp = Z + krow * ZW + Z_BK + kh * 64; const bf16* vp = Z + krow * ZW + Z_BV + kh * 64;
            float s = 0.f;
#pragma unroll
            for (int c8 = 0; c8 < 8; ++c8) { float t8[8]; unpack8(*(const v4u*)(kp + c8 * 8), t8);
#pragma unroll
                for (int i = 0; i < 8; ++i) s += q[c8 * 8 + i] * t8[i]; }
            const float mn = fmaxf(mx, s), al = fast_exp2(mx - mn), p = fast_exp2(s - mn);
            den = den * al + p; mx = mn;
#pragma unroll
            for (int c8 = 0; c8 < 8; ++c8) { float t8[8]; unpack8(*(const v4u*)(vp + c8 * 8), t8);
#pragma unroll
                for (int i = 0; i < 8; ++i) o[c8 * 8 + i] = o[c8 * 8 + i] * al + p * t8[i]; }
        }
        den += fast_exp2(sink[H] * LOG2E - mx);
        const float inv = 1.0f / den;
#pragma unroll
        for (int c8 = 0; c8 < 8; ++c8) { float zz[8], r8[8]; unpack8(*(const v4u*)(Z + (size_t)row * ZW + Z_BZ + H * 64 + c8 * 8), zz);
#pragma unroll
            for (int i = 0; i < 8; ++i) r8[i] = o[c8 * 8 + i] * inv * zz[i];
            *(v4u*)(Z + (size_t)row * ZW + Z_BQ + H * 64 + c8 * 8) = pack8(r8); }
    }
}

__device__ __forceinline__ void phase_d_naive(LAS unsigned char* lds_, const Args& a, int l) {
    Frame F = make_frame(lds_);
    unsigned char* ws = a.ws; bf16* Z = (bf16*)(ws + WS_Z); const float* rpb = a.in[I_RPB] + (size_t)l * 16 * 15 * 31;
    for (int it = F.gtid; it < MROWS * 16; it += F.NT) {
        const int h = it / MROWS, row = it - h * MROWS; const bool isctx = row >= MLAT;
        const int b = isctx ? ((row - MLAT) >> 8) : (row >> 12), pos = row & 4095, r = pos >> 6, c = pos & 63;
        const int r0 = (r - 4 < 0) ? 0 : ((r - 4 > 56) ? 56 : r - 4), c0 = (c - 8 < 0) ? 0 : ((c - 8 > 48) ? 48 : c - 8);
        const int nloc = isctx ? 0 : 128;
        float q[32], o[32];
#pragma unroll
        for (int c8 = 0; c8 < 4; ++c8) { float t8[8]; unpack8(*(const v4u*)(Z + (size_t)row * ZW + Z_DQ + h * 32 + c8 * 8), t8);
#pragma unroll
            for (int i = 0; i < 8; ++i) { q[c8 * 8 + i] = t8[i]; o[c8 * 8 + i] = 0.f; } }
        float mx = -1e30f, den = 0.f;
        for (int t = 0; t < nloc + CTXL; ++t) {
            size_t krow; float bias = 0.f;
            if (t < nloc) { const int i = t >> 4, j = t & 15; krow = (size_t)(b * SEQ + (r0 + i) * 64 + c0 + j); bias = rpb[(h * 15 + (r0 + i - r + 7)) * 31 + (c0 + j - c + 15)] * LOG2E; }
            else krow = (size_t)(MLAT + b * CTXL + (t - nloc));
            const bf16* kp = Z + krow * ZW + Z_DK + h * 32; const bf16* vp = Z + krow * ZW + Z_DV + h * 32;
            float s = bias;
#pragma unroll
            for (int c8 = 0; c8 < 4; ++c8) { float t8[8]; unpack8(*(const v4u*)(kp + c8 * 8), t8);
#pragma unroll
                for (int i = 0; i < 8; ++i) s += q[c8 * 8 + i] * t8[i]; }
            const float mn = fmaxf(mx, s), al = fast_exp2(mx - mn), p = fast_exp2(s - mn);
            den = den * al + p; mx = mn;
#pragma unroll
            for (int c8 = 0; c8 < 4; ++c8) { float t8[8]; unpack8(*(const v4u*)(vp + c8 * 8), t8);
#pragma unroll
                for (int i = 0; i < 8; ++i) o[c8 * 8 + i] = o[c8 * 8 + i] * al + p * t8[i]; }
        }
        const float inv = 1.0f / den;
#pragma unroll
        for (int c8 = 0; c8 < 4; ++c8) { float zz[8], r8[8]; unpack8(*(const v4u*)(Z + (size_t)row * ZW + Z_DZ + h * 32 + c8 * 8), zz);
#pragma unroll
            for (int i = 0; i < 8; ++i) r8[i] = o[c8 * 8 + i] * inv * zz[i];
            *(v4u*)(Z + (size_t)row * ZW + Z_DQ + h * 32 + c8 * 8) = pack8(r8); }
    }
}

__device__ __forceinline__ void phase_gchk(LAS unsigned char* lds_, const Args& a) {
    Frame F = make_frame(lds_); unsigned char* ws = a.ws;
    if (F.gtid < 64 * 64) { const int row = 1000 + ((F.gtid >> 6) * 531) % 30000, col = 3000 + (F.gtid & 63) * 67;
        const signed char* ar = (const signed char*)(ws + WS_N8) + (size_t)row * DM; const signed char* br = (const signed char*)(ws + WS_WG8) + (size_t)col * DM; int s = 0;
#pragma unroll 1
        for (int k = 0; k < DM; ++k) s += (int)ar[k] * (int)br[k];
        const float cm = __builtin_bit_cast(float, ((const unsigned*)(ws + WS_CTL) + CW_CMAX)[col]);
        const float logit = (float)s * ((const float*)(ws + WS_ROWS))[row] * cm * (1.0f / 127.0f);
        const int qref = (int)(255.0f / (1.0f + expf(-logit)) + 0.5f); const int qgot = (int)(ws + WS_G)[(size_t)row * NGATE + col];
        if (qref - qgot > 1 || qgot - qref > 1) atomicAdd((unsigned*)(ws + WS_CTL) + 100, 1u); }
}

typedef short s16x4 __attribute__((ext_vector_type(4)));
__device__ __forceinline__ s16x4 tr_read16(unsigned lds_byte_addr) { return __builtin_amdgcn_ds_read_tr16_b64_v4i16((LAS s16x4*)lds_byte_addr); }
__device__ __forceinline__ bf16x8 cat4(s16x4 a, s16x4 b) { bf16x8 r; r[0] = a[0]; r[1] = a[1]; r[2] = a[2]; r[3] = a[3]; r[4] = b[0]; r[5] = b[1]; r[6] = b[2]; r[7] = b[3]; return r; }
__device__ __forceinline__ bf16x8 pack_p8(const f32x4 a, const f32x4 b) {
    v4u w; w.x = pg8::cvt_pk_bf16(a[0], a[1]); w.y = pg8::cvt_pk_bf16(a[2], a[3]); w.z = pg8::cvt_pk_bf16(b[0], b[1]); w.w = pg8::cvt_pk_bf16(b[2], b[3]);
    return __builtin_bit_cast(bf16x8, w);
}

constexpr int B_NT = 34, B_KR = 0, B_KC = 36864, B_VR = 69632, B_VC = 106496;
__device__ __forceinline__ void b_stage_piece(LAS unsigned char* lds, int kv, int slot_or_ctx, bool ctx, int kk, int ch, const v4u val) {
    const int sw = kv ? (((kk >> 1) & 3) << 1) : ((kk >> 1) & 7);
    const int base = ctx ? (kv ? B_VC : B_KC) : ((kv ? B_VR : B_KR) + slot_or_ctx * 2048);
    *(LAS v4u*)(lds + base + kk * 128 + ((ch ^ sw) << 4)) = val;
}
template <int NT, bool RING>
__device__ __forceinline__ void b_segment(const unsigned ldsb, const int slot0, const bf16x8 (&Qf)[2], const int q16, const int g, const int q0, const int qpos, const bool edge, float& m, float& den, f32x4 (&O)[4]) {
    const int swk = (q16 >> 1) & 7;
    const unsigned klane = ldsb + q16 * 128;
    const unsigned kc0 = ((0 + g) ^ swk) << 4, kc1 = ((4 + g) ^ swk) << 4;
    const int kl = 4 * g + (q16 >> 2);
    const int swv = ((kl >> 1) & 3) << 1;
    const unsigned vlane = ldsb + kl * 128 + ((q16 & 1) << 3);
    unsigned vch[4];
#pragma unroll
    for (int d = 0; d < 4; ++d) vch[d] = vlane + (((2 * d + ((q16 & 3) >> 1)) ^ swv) << 4);
    const int qi = qpos - q0;
    f32x4 dv = (f32x4){0.f, 0.f, 0.f, 0.f};
#pragma unroll
    for (int s = 0; s < NT / 2; ++s) {
        unsigned kt0, vt0;
        if (RING) { int slot = slot0 + 2 * s; slot = slot >= 18 ? slot - 18 : slot; kt0 = B_KR + slot * 2048; vt0 = B_VR + slot * 2048; } else { kt0 = B_KC + 2 * s * 2048; vt0 = B_VC + 2 * s * 2048; }
        f32x4 S2[2];
#pragma unroll
        for (int h = 0; h < 2; ++h) { const bf16x8 Ka = *(const LAS bf16x8*)(klane + kt0 + h * 2048 + kc0), Kb = *(const LAS bf16x8*)(klane + kt0 + h * 2048 + kc1);
            const f32x4 a0 = __builtin_amdgcn_mfma_f32_16x16x32_bf16(Ka, Qf[0], (f32x4){0.f, 0.f, 0.f, 0.f}, 0, 0, 0);
            S2[h] = __builtin_amdgcn_mfma_f32_16x16x32_bf16(Kb, Qf[1], a0, 0, 0, 0); }
        s16x4 Vr[4][2];
#pragma unroll
        for (int d = 0; d < 4; ++d) { Vr[d][0] = tr_read16(vch[d] + vt0); Vr[d][1] = tr_read16(vch[d] + vt0 + 2048); }
        if (RING) {
#pragma unroll
            for (int h = 0; h < 2; ++h) { const int tt = 2 * s + h;
                if (edge) {
#pragma unroll
                    for (int j = 0; j < 4; ++j) { const int kpos = q0 - 128 + 16 * tt + 4 * g + j; const int dlt = kpos - qpos; const bool ok = kpos >= 0 && kpos < SEQ && dlt <= 128 && dlt >= -128; S2[h][j] = ok ? S2[h][j] : -1e30f; }
                } else if (tt < 2) {
#pragma unroll
                    for (int j = 0; j < 4; ++j) S2[h][j] = (16 * tt + 4 * g + j >= qi) ? S2[h][j] : -1e30f;
                } else if (tt >= NT - 2) {
#pragma unroll
                    for (int j = 0; j < 4; ++j) S2[h][j] = (16 * tt + 4 * g + j <= qi + 256) ? S2[h][j] : -1e30f;
                } }
        }
#pragma unroll
        for (int h = 0; h < 2; ++h) { f32x4 x = S2[h] - m;
#pragma unroll
            for (int j = 0; j < 4; ++j) x[j] = fast_exp2(x[j]);
            S2[h] = x; dv += x; }
        const bf16x8 Pf = pack_p8(S2[0], S2[1]);
#pragma unroll
        for (int d = 0; d < 4; ++d) O[d] = __builtin_amdgcn_mfma_f32_16x16x32_bf16(cat4(Vr[d][0], Vr[d][1]), Pf, O[d], 0, 0, 0);
    }
    den += (dv[0] + dv[1]) + (dv[2] + dv[3]);
}
template <bool dry = false>
__device__ __forceinline__ void phase_b_fast(LAS unsigned char* lds_, const Args& a, int l, bool last) {
    Frame F = make_frame(lds_);
    unsigned char* ws = a.ws; bf16* Z = (bf16*)(ws + WS_Z); const float* sink = a.in[I_BSINK] + l * 8;
    const int q16 = F.lane & 15, g = F.lane >> 4;
    const unsigned ldsb = (unsigned)(size_t)F.lds;
    for (int run = blockIdx.x; run < 256; run += F.G) {
        const int b = run >> 5, kh = (run >> 4) & 1, r16 = run & 15, qs0 = 8 * r16;
#pragma unroll 1
        for (int bt = 0; bt < 17; bt += 6) {
            v4u tmp[6];
#pragma unroll
            for (int k = 0; k < 6; ++k) if (bt + k < 17) { const int idx = F.tid + (bt + k) * NTHR; const int key = idx >> 4, c = idx & 15, kv = c >> 3, ch = c & 7;
                int kp = 32 * qs0 - 128 + key; kp = kp < 0 ? 0 : (kp > SEQ - 1 ? SEQ - 1 : kp);
                const size_t grow = key < 288 ? (size_t)(b * SEQ + kp) : (size_t)(MLAT + b * CTXL + (key - 288));
                tmp[k] = *(const v4u*)(Z + grow * ZW + (kv ? Z_BV : Z_BK) + kh * 64 + ch * 8); }
#pragma unroll
            for (int k = 0; k < 6; ++k) if (bt + k < 17) { const int idx = F.tid + (bt + k) * NTHR; const int key = idx >> 4, c = idx & 15, kv = c >> 3, ch = c & 7;
                if (key < 288) b_stage_piece(F.lds, kv, (2 * qs0 + 10 + (key >> 4)) % 18, false, key & 15, ch, tmp[k]);
                else b_stage_piece(F.lds, kv, 0, true, key - 288, ch, tmp[k]); }
        }
        const int nitem = (r16 < 8 && !last) ? 9 : 8;
        const int gi = F.wave >> 1, H = kh * 4 + gi, qi = 16 * (F.wave & 1) + q16;
        bf16x8 Qn[2]; v2u zn[4];
#define PB_LOADQ(it_) do { const bool ic_ = (it_) == 8; const int qs_ = ic_ ? r16 : qs0 + (it_); const size_t qr_ = ic_ ? (size_t)(MLAT + b * CTXL + qs_ * 32 + qi) : (size_t)(b * SEQ + 32 * qs_ + qi); \
            _Pragma("unroll") for (int ks = 0; ks < 2; ++ks) Qn[ks] = *(const bf16x8*)(Z + qr_ * ZW + Z_BQ + H * 64 + 32 * ks + 8 * g); \
            _Pragma("unroll") for (int d = 0; d < 4; ++d) zn[d] = *(const v2u*)(Z + qr_ * ZW + Z_BZ + H * 64 + d * 16 + 4 * g); } while (0)
        PB_LOADQ(0);
        __syncthreads();
#pragma unroll 1
        for (int it = 0; it < nitem; ++it) {
            const bool isctx = it == 8; const int qs = isctx ? r16 : qs0 + it; const int q0 = isctx ? 0 : 32 * qs;
            const bool pf = it < 7; v4u pfv = (v4u){0u, 0u, 0u, 0u}; const int pkey = F.tid >> 4, pc = F.tid & 15;
            if (pf) { int kp = 32 * (qs + 1) + 128 + pkey; kp = kp > SEQ - 1 ? SEQ - 1 : kp;
                pfv = *(const v4u*)(Z + (size_t)(b * SEQ + kp) * ZW + ((pc >> 3) ? Z_BV : Z_BK) + kh * 64 + (pc & 7) * 8); }
            const size_t qrow = isctx ? (size_t)(MLAT + b * CTXL + qs * 32 + qi) : (size_t)(b * SEQ + q0 + qi);
            bf16x8 Qf[2]; v2u zz[4];
#pragma unroll
            for (int ks = 0; ks < 2; ++ks) Qf[ks] = Qn[ks];
#pragma unroll
            for (int d = 0; d < 4; ++d) zz[d] = zn[d];
            if (it + 1 < nitem) PB_LOADQ(it + 1);
            __builtin_amdgcn_sched_barrier(0);
            const int slot0 = (2 * qs + 10) % 18;
            const int qpos = q0 + qi; const float sk = sink[H] * LOG2E;
            float mx = 0.f, den = 0.f;
            f32x4 O[4];
#pragma unroll
            for (int d = 0; d < 4; ++d) O[d] = (f32x4){0.f, 0.f, 0.f, 0.f};
            b_segment<16, false>(ldsb, slot0, Qf, q16, g, q0, qpos, false, mx, den, O);
            if (!isctx) b_segment<18, true>(ldsb, slot0, Qf, q16, g, q0, qpos, (qs < 4) || (qs >= 123), mx, den, O);
            den += __shfl_xor(den, 16); den += __shfl_xor(den, 32);
            den += fast_exp2(sk - mx);
            const float inv = 1.0f / den;
#pragma unroll
            for (int d = 0; d < 4; ++d) {
                const int dd = H * 64 + d * 16 + 4 * g;
                v2u o; o.x = pg8::cvt_pk_bf16(O[d][0] * inv * bflo(zz[d].x), O[d][1] * inv * bfhi(zz[d].x)); o.y = pg8::cvt_pk_bf16(O[d][2] * inv * bflo(zz[d].y), O[d][3] * inv * bfhi(zz[d].y));
                if (!dry) *(v2u*)(Z + qrow * ZW + Z_BQ + dd) = o; else asm volatile("" :: "v"(o.x), "v"(o.y));
            }
            __syncthreads();
            if (pf) b_stage_piece(F.lds, pc >> 3, (2 * (qs + 1) + 26 + (pkey >> 4)) % 18, false, pkey & 15, pc & 7, pfv);
            __syncthreads();
        }
#undef PB_LOADQ
    }
}

constexpr int D_KL = 0, D_KC = 36864, D_VL = 53248, D_VC = 90112, D_BIAS = 106496;
__device__ __forceinline__ void d_stage_piece(LAS unsigned char* lds, int kv, int slot, bool ctx, int kk, int ch, const v4u val) {
    const int sw = kv ? (((kk >> 2) & 1) << 1) : 0;
    const int base = ctx ? (kv ? D_VC : D_KC) : ((kv ? D_VL : D_KL) + slot * 4096);
    *(LAS v4u*)(lds + base + kk * 64 + ((ch ^ sw) << 4)) = val;
}
template <bool LOCAL>
__device__ __forceinline__ void d_segment(const unsigned ldsb, const int m0, const int cw, const bf16x8 Qf, const int q16, const int g, const int r, const int r0, const int c, const int c0,
                                          const float* rb, float& m, float& den, f32x4 (&O)[2]) {
    unsigned bbase = ldsb + D_BIAS + 4 * ((r0 - r + 7) * 31 + (cw + 4 * g - c + 15));
    if (LOCAL) asm volatile("" : "+v"(bbase));
    const unsigned klane = ldsb + q16 * 64 + (g << 4);
    const int kl = 4 * g + (q16 >> 2);
    const int swv = (g & 1) << 1;
    const unsigned vlane = ldsb + kl * 64 + ((q16 & 1) << 3);
    unsigned vch[2];
#pragma unroll
    for (int d = 0; d < 2; ++d) vch[d] = vlane + (((2 * d + ((q16 & 3) >> 1)) ^ swv) << 4);
    f32x4 dv = (f32x4){0.f, 0.f, 0.f, 0.f};
#pragma unroll
    for (int s = 0; s < 8; ++s) {
        unsigned kt0, vt0;
        if (LOCAL) { int slot = m0 + s; slot = slot >= 9 ? slot - 9 : slot; kt0 = D_KL + slot * 4096 + cw * 64; vt0 = D_VL + slot * 4096 + cw * 64; } else { kt0 = D_KC + 32 * s * 64; vt0 = D_VC + 32 * s * 64; }
        f32x4 S2[2], bv[2];
        bv[0] = (f32x4){0.f, 0.f, 0.f, 0.f}; bv[1] = bv[0];
        bf16x8 Kf[2];
#pragma unroll
        for (int h = 0; h < 2; ++h) Kf[h] = *(const LAS bf16x8*)(klane + kt0 + h * 16 * 64);
        if (LOCAL) {
#pragma unroll
            for (int h = 0; h < 2; ++h)
#pragma unroll
                for (int j = 0; j < 4; ++j) bv[h][j] = *(const LAS float*)(bbase + 4 * (s * 31 + 16 * h + j));
            asm volatile("" : "+v"(bv[0]), "+v"(bv[1]));
        }
#pragma unroll
        for (int h = 0; h < 2; ++h) S2[h] = __builtin_amdgcn_mfma_f32_16x16x32_bf16(Kf[h], Qf, bv[h], 0, 0, 0);
        s16x4 Vr[2][2];
#pragma unroll
        for (int d = 0; d < 2; ++d) { Vr[d][0] = tr_read16(vch[d] + vt0); Vr[d][1] = tr_read16(vch[d] + vt0 + 16 * 64); }
        if (LOCAL) {
#pragma unroll
            for (int h = 0; h < 2; ++h)
#pragma unroll
                for (int j = 0; j < 4; ++j) { const int cc = cw + 16 * h + 4 * g + j; const bool ok = (unsigned)(cc - c0) < 16u;
                    S2[h][j] = ok ? S2[h][j] : -1e30f; }
        }
#pragma unroll
        for (int h = 0; h < 2; ++h) { f32x4 x = S2[h] - m;
#pragma unroll
            for (int j = 0; j < 4; ++j) x[j] = fast_exp2(x[j]);
            S2[h] = x; dv += x; }
        const bf16x8 Pf = pack_p8(S2[0], S2[1]);
#pragma unroll
        for (int d = 0; d < 2; ++d) O[d] = __builtin_amdgcn_mfma_f32_16x16x32_bf16(cat4(Vr[d][0], Vr[d][1]), Pf, O[d], 0, 0, 0);
    }
    den += (dv[0] + dv[1]) + (dv[2] + dv[3]);
}
__device__ __forceinline__ int d_rbase(int rp) { const int t = 2 * rp - 4; return t < 0 ? 0 : (t > 56 ? 56 : t); }
template <bool dry = false>
__device__ __forceinline__ void phase_d_fast(LAS unsigned char* lds_, const Args& a, int l, bool last) {
    Frame F = make_frame(lds_);
    unsigned char* ws = a.ws; bf16* Z = (bf16*)(ws + WS_Z); const float* rpb = a.in[I_RPB] + (size_t)l * 16 * 15 * 31;
    const int q16 = F.lane & 15, g = F.lane >> 4;
    const unsigned ldsb = (unsigned)(size_t)F.lds;
    for (int run = blockIdx.x; run < 256; run += F.G) {
        const int h = run & 15, half = (run >> 4) & 1, b = run >> 5, rp0 = 16 * half;
        if (F.tid < 465) ((LAS float*)(F.lds + D_BIAS))[F.tid] = rpb[h * 465 + F.tid] * LOG2E;
        const int rb0 = d_rbase(rp0);
#pragma unroll 1
        for (int bt = 0; bt < 13; bt += 7) {
            v4u tmp[7];
#pragma unroll
            for (int k = 0; k < 7; ++k) if (bt + k < 13) { const int idx = F.tid + (bt + k) * NTHR; const int key = idx >> 3, c = idx & 7, kv = c >> 2, ch = c & 3;
                size_t grow;
                if (key < 576) { int gr = rb0 + (key >> 6); gr = gr > 63 ? 63 : gr; grow = (size_t)(b * SEQ + gr * 64 + (key & 63)); }
                else grow = (size_t)(MLAT + b * CTXL + (key - 576));
                tmp[k] = *(const v4u*)(Z + grow * ZW + (kv ? Z_DV : Z_DK) + h * 32 + ch * 8); }
#pragma unroll
            for (int k = 0; k < 7; ++k) if (bt + k < 13) { const int idx = F.tid + (bt + k) * NTHR; const int key = idx >> 3, c = idx & 7, kv = c >> 2, ch = c & 3;
                if (key < 576) d_stage_piece(F.lds, kv, (rb0 + (key >> 6)) % 9, false, key & 63, ch, tmp[k]);
                else d_stage_piece(F.lds, kv, 0, true, key - 576, ch, tmp[k]); }
        }
        const int nitD = last ? 16 : 17;
        bf16x8 Qn; v2u zn[2];
#define PD_LOADQ(it_) do { const bool ic_ = (it_) == 16; const int rp_ = ic_ ? rp0 + 15 : rp0 + (it_); \
            const size_t qr_ = ic_ ? (size_t)(MLAT + b * CTXL + half * 128 + F.wave * 16 + q16) : (size_t)(b * SEQ + (2 * rp_ + (F.wave >> 2)) * 64 + 16 * (F.wave & 3) + q16); \
            Qn = *(const bf16x8*)(Z + qr_ * ZW + Z_DQ + h * 32 + 8 * g); \
            _Pragma("unroll") for (int d = 0; d < 2; ++d) zn[d] = *(const v2u*)(Z + qr_ * ZW + Z_DZ + h * 32 + d * 16 + 4 * g); } while (0)
        PD_LOADQ(0);
        __syncthreads();
#pragma unroll 1
        for (int it = 0; it < nitD; ++it) {
            const bool isctx = it == 16; const int rp = isctx ? rp0 + 15 : rp0 + it;
            const int re = 2 * rp, rbase = d_rbase(rp);
            const bool pf = (it < 15) && (d_rbase(rp + 1) != rbase);
            v4u pfv[2]; pfv[0] = (v4u){0u, 0u, 0u, 0u}; pfv[1] = pfv[0];
            if (pf) {
#pragma unroll
                for (int k = 0; k < 2; ++k) { const int idx = F.tid + k * NTHR; const int key = idx >> 3, c = idx & 7; int gr = rbase + 9 + (key >> 6); gr = gr > 63 ? 63 : gr;
                    pfv[k] = *(const v4u*)(Z + (size_t)(b * SEQ + gr * 64 + (key & 63)) * ZW + ((c >> 2) ? Z_DV : Z_DK) + h * 32 + (c & 3) * 8); }
            }
            const int r = re + (F.wave >> 2), js = F.wave & 3, c = 16 * js + q16;
            const int r0 = (r - 4 < 0) ? 0 : ((r - 4 > 56) ? 56 : r - 4), c0 = (c - 8 < 0) ? 0 : ((c - 8 > 48) ? 48 : c - 8);
            const int cw = (js == 0) ? 0 : ((js == 1) ? 8 : ((js == 2) ? 24 : 32));
            const size_t qrow = isctx ? (size_t)(MLAT + b * CTXL + half * 128 + F.wave * 16 + q16) : (size_t)(b * SEQ + r * 64 + c);
            const bf16x8 Qf = Qn;
            v2u zz[2];
#pragma unroll
            for (int d = 0; d < 2; ++d) zz[d] = zn[d];
            if (it + 1 < nitD) PD_LOADQ(it + 1);
            __builtin_amdgcn_sched_barrier(0);
            const int m0 = r0 % 9;
            const float* rb = rpb + (size_t)h * 15 * 31;
            float mx = 0.f, den = 0.f;
            f32x4 O[2];
            O[0] = (f32x4){0.f, 0.f, 0.f, 0.f}; O[1] = (f32x4){0.f, 0.f, 0.f, 0.f};
            d_segment<false>(ldsb, m0, cw, Qf, q16, g, r, r0, c, c0, rb, mx, den, O);
            if (!isctx) d_segment<true>(ldsb, m0, cw, Qf, q16, g, r, r0, c, c0, rb, mx, den, O);
            den += __shfl_xor(den, 16); den += __shfl_xor(den, 32);
            const float inv = 1.0f / den;
#pragma unroll
            for (int d = 0; d < 2; ++d) {
                const int dd = h * 32 + d * 16 + 4 * g;
                v2u o; o.x = pg8::cvt_pk_bf16(O[d][0] * inv * bflo(zz[d].x), O[d][1] * inv * bfhi(zz[d].x)); o.y = pg8::cvt_pk_bf16(O[d][2] * inv * bflo(zz[d].y), O[d][3] * inv * bfhi(zz[d].y));
                if (!dry) *(v2u*)(Z + qrow * ZW + Z_DQ + dd) = o; else asm volatile("" :: "v"(o.x), "v"(o.y));
            }
            __syncthreads();
            if (pf) {
#pragma unroll
                for (int k = 0; k < 2; ++k) { const int idx = F.tid + k * NTHR; const int key = idx >> 3, c2 = idx & 7; d_stage_piece(F.lds, c2 >> 2, (rbase + 9 + (key >> 6)) % 9, false, key & 63, c2 & 3, pfv[k]); }
            }
            __syncthreads();
        }
#undef PD_LOADQ
    }
}

__device__ __forceinline__ void phase_c1_fast(LAS unsigned char* lds_, const Args& a, int l, bool last) {
    Frame F = make_frame(lds_);
    unsigned char* ws = a.ws; const bf16* Z = (const bf16*)(ws + WS_Z);
    const bf16* mt = (const bf16*)(ws + WS_MT) + (size_t)l * 4 * 2 * 128 * 128;
    bf16* fct = (bf16*)(ws + WS_NBUF); bf16* fst = (bf16*)(ws + WS_NBUF + FST_OFF); bf16* utc = (bf16*)(ws + WS_NBUF + UT_CTX_OFF); float* uch = (float*)(ws + WS_UCH);
    const int q16 = F.lane & 15, g4 = F.lane >> 4;
    const int nitem = last ? 512 : 512 + 64;
    for (int item = blockIdx.x; item < nitem; item += F.G) {
        const bool isctx = item >= 512; const int r_ = isctx ? item - 512 : item;
        const int chunk = isctx ? (r_ & 1) : (r_ & 15), g = isctx ? ((r_ >> 1) & 3) : ((r_ >> 4) & 3), b = isctx ? (r_ >> 3) : (r_ >> 6);
        {   v4u t1[4], t2[4];
#pragma unroll
            for (int k = 0; k < 4; ++k) { const int idx = F.tid + k * NTHR; const int pos = idx >> 4, ch = idx & 15; const int lpos = chunk * 128 + pos;
                const size_t r1 = isctx ? (size_t)(MLAT + b * CTXL + lpos) : (size_t)(b * SEQ + lpos), r2 = isctx ? r1 : (size_t)(b * SEQ + ((SEQ - lpos) & (SEQ - 1)));
                t1[k] = *(const v4u*)(Z + r1 * ZW + Z_FIN + g * 128 + ch * 8); t2[k] = *(const v4u*)(Z + r2 * ZW + Z_FIN + g * 128 + ch * 8); }
#pragma unroll
            for (int k = 0; k < 4; ++k) { const int idx = F.tid + k * NTHR; const int pos = idx >> 4, ch = idx & 15; const int lpos = chunk * 128 + pos;
                const int off = pos * 256 + ((ch ^ (pos & 15)) << 4);
                if (isctx) { *(LAS v4u*)(F.lds + off) = t1[k]; }
                else { float x1[8], x2[8], sp[8], sm[8]; unpack8(t1[k], x1); unpack8(t2[k], x2); const bool z0 = (lpos == 0);
#pragma unroll
                    for (int i = 0; i < 8; ++i) { sp[i] = z0 ? x1[i] : (x1[i] + x2[i]); sm[i] = x1[i] - x2[i]; }
                    *(LAS v4u*)(F.lds + off) = pack8(sp); *(LAS v4u*)(F.lds + 32768 + off) = pack8(sm); } }
        }
        __syncthreads();
        const unsigned img = (!isctx && F.wave >= 4) ? 32768u : 0u;
        bf16x8 Bf[2][4];
#pragma unroll
        for (int nt = 0; nt < 2; ++nt) { const int dp = F.wave * 32 + nt * 16 + q16;
#pragma unroll
            for (int ks = 0; ks < 4; ++ks) Bf[nt][ks] = *(const bf16x8*)(mt + ((size_t)(g * 2 + (dp >> 7)) * 128 + (dp & 127)) * 128 + 32 * ks + 8 * g4); }
#pragma unroll
        for (int m = 0; m < 8; ++m) {
            const int pos = 16 * m + q16;
            f32x4 acc[2]; acc[0] = (f32x4){0.f, 0.f, 0.f, 0.f}; acc[1] = (f32x4){0.f, 0.f, 0.f, 0.f};
            bf16x8 Af[4];
#pragma unroll
            for (int ks = 0; ks < 4; ++ks) Af[ks] = *(const LAS bf16x8*)(F.lds + img + pos * 256 + (((ks * 4 + g4) ^ (pos & 15)) << 4));
#pragma unroll
            for (int ks = 0; ks < 4; ++ks)
#pragma unroll
                for (int nt = 0; nt < 2; ++nt) acc[nt] = __builtin_amdgcn_mfma_f32_16x16x32_bf16(Af[ks], Bf[nt][ks], acc[nt], 0, 0, 0);
#pragma unroll
            for (int nt = 0; nt < 2; ++nt) { const int dp = F.wave * 32 + nt * 16 + q16, part = dp >> 7, dd = dp & 127;
                v2u o; o.x = pg8::cvt_pk_bf16(acc[nt][0], acc[nt][1]); o.y = pg8::cvt_pk_bf16(acc[nt][2], acc[nt][3]);
                bf16* dst = isctx ? utc + ((size_t)b * 512 + g * 128 + dd) * 512 + part * 256 + chunk * 128 + 16 * m + 4 * g4
                                  : (part ? fst : fct) + ((size_t)b * 512 + g * 128 + dd) * 2048 + chunk * 128 + 16 * m + 4 * g4;
                *(v2u*)dst = o; }
        }
        if (!isctx && chunk == 0 && F.tid < 128) {
            const bf16* xr = Z + (size_t)(b * SEQ + 2048) * ZW + Z_FIN + g * 128; const bf16* mr = mt + ((size_t)(g * 2 + 0) * 128 + F.tid) * 128; float s = 0.f;
#pragma unroll 4
            for (int c8 = 0; c8 < 16; ++c8) { float x[8], w[8]; unpack8(*(const v4u*)(xr + c8 * 8), x); unpack8(*(const v4u*)(mr + c8 * 8), w);
#pragma unroll
                for (int i = 0; i < 8; ++i) s += x[i] * w[i]; }
            uch[b * 512 + g * 128 + F.tid] = s;
        }
        __syncthreads();
    }
}
__device__ __forceinline__ void phase_c2_rowh(LAS unsigned char* lds_, const Args& a) {
    Frame F = make_frame(lds_);
    unsigned char* ws = a.ws; bf16* Z = (bf16*)(ws + WS_Z); const bf16* fct = (const bf16*)(ws + WS_NBUF); const float* uch = (const float*)(ws + WS_UCH);
    for (int it0 = F.gw; it0 < NB * 512; it0 += 2 * F.NGW) {
        v4u t4[2][4]; float ue[2], ze[2];
#pragma unroll
        for (int q = 0; q < 2; ++q) { const int it = it0 + q * F.NGW; const bool ok = it < NB * 512; const int itc = ok ? it : it0;
            const int b = itc >> 9, d = itc & 511; const bf16* rp = Z + ((size_t)b * SEQ + 2048) * ZW;
#pragma unroll
            for (int j = 0; j < 4; ++j) t4[q][j] = *(const v4u*)(fct + (size_t)itc * 2048 + j * 512 + F.lane * 8);
            ue[q] = uch[itc]; ze[q] = bf2f(rp[Z_FZ + d]); }
        __builtin_amdgcn_sched_barrier(0);
#pragma unroll
        for (int q = 0; q < 2; ++q) { const int it = it0 + q * F.NGW; float s = 0.f;
#pragma unroll
            for (int j = 0; j < 4; ++j) { float x[8]; unpack8(t4[q][j], x); s += ((x[0] - x[1]) + (x[2] - x[3])) + ((x[4] - x[5]) + (x[6] - x[7])); }
            s = wave_sum(s);
            if (F.lane == 0 && it < NB * 512) { const int b = it >> 9, d = it & 511; bf16* rp = Z + ((size_t)b * SEQ + 2048) * ZW;
                rp[Z_FIN + d] = (bf16)f2bf((s + ue[q]) * 0.0013810679320049757f * ze[q]); } }
    }
}

template <bool dry = false>
__device__ __forceinline__ void phase_a_fast(LAS unsigned char* lds_, const Args& a, int l, bool last) {
    Frame F = make_frame(lds_);
    unsigned char* ws = a.ws; bf16* Z = (bf16*)(ws + WS_Z); const float* rstda = (const float*)(ws + WS_RSTDA);
    const bf16* wsb = (const bf16*)(ws + WS_WSB) + (size_t)l * 4 * 128 * 128; const float* bsp = a.in[I_ABS] + l * 4 * 128; const float* gv = a.in[I_ANG] + l * 512;
    const int q16 = F.lane & 15, g4 = F.lane >> 4;
    const unsigned ldsb = (unsigned)(size_t)F.lds;
    const int nitemA = (last ? MLAT / 128 : MROWS / 128) * 8;
    v4u tmp[2]; float rs[2];
#define PA_LOAD1(it_) do { const int ch2_ = (it_) & 1, g_ = ((it_) >> 1) & 3; const size_t r0_ = (size_t)((it_) >> 3) * 128; const int cb_ = g_ * 128 + ch2_ * 64; \
        _Pragma("unroll") for (int k = 0; k < 2; ++k) { const int idx = F.tid + k * NTHR; const int s = idx >> 3, ch = idx & 7; tmp[k] = *(const v4u*)(Z + (r0_ + s) * ZW + Z_AV + cb_ + ch * 8); rs[k] = rstda[r0_ + s]; } } while (0)
    const int cb_ = (int)blockIdx.x; const bool bal = (F.G == 256) && !last;
    const bool inS = bal && ((cb_ >= 136 && cb_ < 144) || (cb_ >= 152 && cb_ < 160));
    const bool inL = bal && cb_ >= 168 && cb_ < 224 && ((cb_ - 168) & 15) < 8;
    int extra = -1;
    if (bal) { if (cb_ < 128) extra = 2048 + cb_; else if (inL) { const int k = ((cb_ - 168) >> 4) * 8 + (cb_ & 7), m = k >> 1; extra = ((m < 8) ? 136 + m : 144 + m) + 256 * (6 + (k & 1)); } }
    const int nbase = bal ? (inS ? 6 : 8) : (nitemA - cb_ + F.G - 1) / F.G, nmine = nbase + (extra >= 0 ? 1 : 0);
#define PA_ITEM(j_) (((j_) < nbase) ? cb_ + (j_) * F.G : extra)
    const int t = 16 * F.wave + q16;
    v2u wlo[4], whi[4]; float biasn; v2u uun[4], zzn[4]; f32x4 gnn[4];
#define PA_LOAD2(it_) do { const int ch2_ = (it_) & 1, g_ = ((it_) >> 1) & 3; const size_t rw_ = (size_t)((it_) >> 3) * 128 + t; const int cb2_ = g_ * 128 + ch2_ * 64; \
        _Pragma("unroll") for (int ks = 0; ks < 4; ++ks) { const bf16* wp = wsb + ((size_t)g_ * 128 + t) * 128 + 32 * ks + 4 * g4; wlo[ks] = *(const v2u*)wp; whi[ks] = *(const v2u*)(wp + 16); } \
        biasn = bsp[g_ * 128 + t]; \
        _Pragma("unroll") for (int ct = 0; ct < 4; ++ct) { const int cc = cb2_ + ct * 16 + 4 * g4; uun[ct] = *(const v2u*)(Z + rw_ * ZW + Z_AU + cc); zzn[ct] = *(const v2u*)(Z + rw_ * ZW + Z_AZ + cc); gnn[ct] = *(const f32x4*)(gv + cc); } } while (0)
    if (nmine > 0) { PA_LOAD1(PA_ITEM(0)); PA_LOAD2(PA_ITEM(0)); }
    for (int ji = 0; ji < nmine; ++ji) {
        const int item = PA_ITEM(ji);
        const int ch2 = item & 1, g = (item >> 1) & 3, chunk = item >> 3; const size_t row0 = (size_t)chunk * 128; const int cbase = g * 128 + ch2 * 64;
        bf16x8 Bf[4];
#pragma unroll
        for (int ks = 0; ks < 4; ++ks) { v4u w; w.x = wlo[ks].x; w.y = wlo[ks].y; w.z = whi[ks].x; w.w = whi[ks].y; Bf[ks] = __builtin_bit_cast(bf16x8, w); }
        const size_t row = row0 + t; const float bias = biasn;
        v2u uu[4], zz[4]; f32x4 gn[4];
#pragma unroll
        for (int ct = 0; ct < 4; ++ct) { uu[ct] = uun[ct]; zz[ct] = zzn[ct]; gn[ct] = gnn[ct]; }
#pragma unroll
        for (int k = 0; k < 2; ++k) { const int idx = F.tid + k * NTHR; const int s = idx >> 3, ch = idx & 7; float x[8]; unpack8(tmp[k], x);
#pragma unroll
            for (int i = 0; i < 8; ++i) x[i] *= rs[k];
            *(LAS v4u*)(F.lds + s * 128 + ((ch ^ (((s >> 1) & 3) << 1)) << 4)) = pack8(x); }
        __syncthreads();
        if (ji + 1 < nmine) { PA_LOAD1(PA_ITEM(ji + 1)); PA_LOAD2(PA_ITEM(ji + 1)); }
        __builtin_amdgcn_sched_barrier(0);
        f32x4 acc[4];
#pragma unroll
        for (int ct = 0; ct < 4; ++ct) acc[ct] = (f32x4){0.f, 0.f, 0.f, 0.f};
#pragma unroll
        for (int ks = 0; ks < 4; ++ks) {
            const int s0 = 32 * ks + 4 * g4 + (q16 >> 2), s1 = s0 + 16;
            s16x4 Av[4][2];
#pragma unroll
            for (int ct = 0; ct < 4; ++ct) { const int chn = 2 * ct + ((q16 & 3) >> 1);
                Av[ct][0] = tr_read16(ldsb + s0 * 128 + ((chn ^ (((s0 >> 1) & 3) << 1)) << 4) + ((q16 & 1) << 3));
                Av[ct][1] = tr_read16(ldsb + s1 * 128 + ((chn ^ (((s1 >> 1) & 3) << 1)) << 4) + ((q16 & 1) << 3)); }
#pragma unroll
            for (int ct = 0; ct < 4; ++ct) acc[ct] = __builtin_amdgcn_mfma_f32_16x16x32_bf16(cat4(Av[ct][0], Av[ct][1]), Bf[ks], acc[ct], 0, 0, 0);
        }
#pragma unroll
        for (int ct = 0; ct < 4; ++ct) {
            const int cc = cbase + ct * 16 + 4 * g4;
            v2u o; o.x = pg8::cvt_pk_bf16(bflo(uu[ct].x) * (acc[ct][0] * gn[ct][0] + bias) * bflo(zz[ct].x), bfhi(uu[ct].x) * (acc[ct][1] * gn[ct][1] + bias) * bfhi(zz[ct].x));
            o.y = pg8::cvt_pk_bf16(bflo(uu[ct].y) * (acc[ct][2] * gn[ct][2] + bias) * bflo(zz[ct].y), bfhi(uu[ct].y) * (acc[ct][3] * gn[ct][3] + bias) * bfhi(zz[ct].y));
            if (!dry) *(v2u*)(Z + row * ZW + Z_AU + cc) = o; else asm volatile("" :: "v"(o.x), "v"(o.y));
        }
        __syncthreads();
    }
#undef PA_LOAD1
#undef PA_LOAD2
#undef PA_ITEM
}

constexpr int NPHASE = 1 + 6 * DEPTH;
#ifndef REP_P2
#define REP_P2 1
#endif
#ifndef REP_M1
#define REP_M1 1
#endif
#ifndef REP_C2
#define REP_C2 1
#endif
#ifndef REP_PRO
#define REP_PRO 1
#endif
#ifndef REP_X1
#define REP_X1 1
#endif
#ifndef REP_M2L0
#define REP_M2L0 1
#endif
#ifndef DRY_A
#define DRY_A 0
#endif
#ifndef DRY_B
#define DRY_B 0
#endif
#ifndef DRY_D
#define DRY_D 0
#endif
#ifndef PROBE_P2NULL
#define PROBE_P2NULL 0
#endif
#ifndef M2_STAGGER
#define M2_STAGGER 2
#endif
#ifndef PROBE_GCHK
#define PROBE_GCHK 0
#endif
#ifndef REP_NORM
#define REP_NORM 1
#endif
__global__ void __launch_bounds__(NTHR, 2) fwd_kernel(Args args) {
    extern __shared__ __attribute__((aligned(16))) unsigned char lds_raw[];
    LAS unsigned char* const lds = (LAS unsigned char*)lds_raw;
    const int G = gridDim.x;
    unsigned char* ws = args.ws;
    volatile LAS unsigned* MISC = (volatile LAS unsigned*)(lds + MISC_OFF);
    if (threadIdx.x < 32) MISC[threadIdx.x] = 0u;
    __syncthreads();
    XcdBarrier bar = xcd_barrier_post((unsigned*)(ws + WS_CTL) + CW_BAR, MISC + 8);
    const int lo = args.ph_lo, hi = args.ph_hi;
#define IN(k) (lo <= (k) && (k) < hi)
#define SEAM(k) do { if (IN(k) && IN((k) + 1)) xcd_barrier(bar); } while (0)

    if (IN(0)) {
      for (int rep = 0; rep < REP_PRO; ++rep) {
        Frame F = make_frame(lds);
        build_costab(F);
        pro_mod(F, args.in[I_C], args.in[I_CCTX], args.in[I_WADA], args.in[I_BADA], args.in[I_NORMG], (float*)(ws + WS_MOD));
        pro_colmax(F, args.in[I_WGATE], (unsigned*)(ws + WS_CTL) + CW_CMAX);
        pro_tables(F, args.in[I_CWF], (bf16*)(ws + WS_COS2), (bf16*)(ws + WS_SIN2), (bf16*)(ws + WS_DFTC), (f32x2*)(ws + WS_ROPE), (bf16*)(ws + WS_MT), args.in[I_AWS], (bf16*)(ws + WS_WSB));
        __syncthreads();
      }
    }
    SEAM(0);
#pragma unroll 1
    for (int l = 0; l < DEPTH; ++l) {
        const int pb = 1 + 6 * l;
        if (IN(pb + 0)) { if (l == 0) phase_convert(lds, args, 0, 0, CV_ALL, nullptr); for (int rep = 0; rep < REP_NORM; ++rep) { phase_norm(lds, args, l); __syncthreads(); } }
        SEAM(pb + 0);
        if (IN(pb + 1)) {
          if (PROBE_P2NULL) {
            PlainProb P{(const char*)(ws + WS_NBUF), (const char*)(ws + WS_WCAT), DM * 2, DM * 2, DM};
            pg8::StaticOrder S; S.init(MROWS / 256, N1 / 256, G, (int)blockIdx.x);
            EpiNull E{};
            pg8::gemm_phase<PlainProb, EpiNull, true, true>(lds, P, S, E);
          }
#pragma unroll 1
          for (int rep = 0; rep < REP_P2; ++rep) {
            PlainProb P{(const char*)(ws + WS_NBUF), (const char*)(ws + WS_WCAT), DM * 2, DM * 2, DM};
            P2Order S; S.init(G, (int)blockIdx.x, l == DEPTH - 1, i8_layer(l) ? ZW / 256 : N1 / 256);
            EpiP2 E{(bf16*)(ws + WS_Z), ws + WS_G, args.in[I_BQG] + l * 64, args.in[I_BKG] + l * 64, args.in[I_DQG] + l * 32, args.in[I_DKG] + l * 32, (const f32x2*)(ws + WS_ROPE)};
            const int nfull = S.full.nwg / G, nrem = S.full.nwg - nfull * G;
            const bool halves = (l != DEPTH - 1) && nrem > 0 && 2 * nrem <= G;
            if (halves) S.maxi = nfull;
            pg8::gemm_phase<PlainProb, EpiP2, true, true, P2Order>(lds, P, S, E);
            if (halves) {
                const int hc = (int)blockIdx.x; const bool act = hc < 2 * nrem;
                pg8::StaticOrder T1 = S.full; T1.c = act ? (hc >> 1) : 0; pg8::Unit hu; hu.pm = 0; hu.pn = 0; (void)T1.next(nfull, hu);
                const int rowbase = hu.pm * 256 + (hc & 1) * 128;
                pg8::gemm_phase_half<EpiP2>(lds, P.A + (size_t)rowbase * P.lda, P.B + (size_t)hu.pn * 256 * P.ldb, P.lda, P.ldb, P.K, act, E, rowbase, hu.pn);
            }
            if (i8_layer(l)) {
                PlainProb Pg{(const char*)(ws + WS_N8), (const char*)(ws + WS_WG8), DM, DM, DM / 2};
                pg8::StaticOrder Sg; Sg.init((l == DEPTH - 1) ? MLAT / 256 : MROWS / 256, NGATE / 256, G, (int)blockIdx.x);
                EpiGate Eg{ws + WS_G, (const float*)(ws + WS_ROWS), (const unsigned*)(ws + WS_CTL) + CW_CMAX + (size_t)l * 8192};
                pg8::gemm_phase<PlainProb, EpiGate, true, true, pg8::StaticOrder, true>(lds, Pg, Sg, Eg);
            }
          }
          if (l > 0) phase_convert(lds, args, l, CV_IN + CV_GT + CV_BR, CV_ALL, (unsigned*)(ws + WS_CTL) + CW_CVQ + 64 * (2 * l));
        }
        SEAM(pb + 1);
        if (PROBE_GCHK && l == 0 && IN(pb + 2)) phase_gchk(lds, args);
        if (IN(pb + 2)) { for (int rep = 0; rep < REP_X1; ++rep) { phase_x1(lds, args, l, l == DEPTH - 1); phase_c1_fast(lds, args, l, l == DEPTH - 1); } }
        SEAM(pb + 2);
        if (IN(pb + 3)) {
#pragma unroll 1
          for (int rep = 0; rep < REP_C2; ++rep) {
            {
                pg8::C2Prob P{(const char*)(ws + WS_COS2), (const char*)(ws + WS_SIN2), (const char*)(ws + WS_NBUF), (const char*)(ws + WS_NBUF + FST_OFF), (const float*)(ws + WS_UCH), (bf16*)(ws + WS_Z), 0.0013810679320049757f  };
                pg8::gemm_phase_c2(lds, P, G, (int)blockIdx.x);
                phase_c2_rowh(lds, args);
            }
            if (l + 1 < DEPTH) {
                DftCtxProb P{(const char*)(ws + WS_DFTC), (const char*)(ws + WS_NBUF + UT_CTX_OFF), 512 * 2, 512 * 2, 512};
                CtxDftOrder S{G, (int)blockIdx.x};
                EpiC2 E{(bf16*)(ws + WS_Z), MLAT, 0.005524271728019903f  };
                pg8::gemm_phase<DftCtxProb, EpiC2, true, true, CtxDftOrder>(lds, P, S, E);
            }
          }
#pragma unroll 1
            for (int rep = 0; rep < DRY_A; ++rep) phase_a_fast<true>(lds, args, l, l == DEPTH - 1);
            phase_a_fast(lds, args, l, l == DEPTH - 1);
#pragma unroll 1
            for (int rep = 0; rep < DRY_B; ++rep) phase_b_fast<true>(lds, args, l, l == DEPTH - 1);
            phase_b_fast(lds, args, l, l == DEPTH - 1);
#pragma unroll 1
            for (int rep = 0; rep < DRY_D; ++rep) phase_d_fast<true>(lds, args, l, l == DEPTH - 1);
            phase_d_fast(lds, args, l, l == DEPTH - 1);
        }
        SEAM(pb + 3);
        if (IN(pb + 4)) {
#pragma unroll 1
          for (int rep = 0; rep < REP_M1; ++rep) {
            pg8::M1Prob P{(const char*)(ws + WS_Z), (const char*)(ws + WS_WBR), ws + WS_G, (bf16*)(ws + WS_NBUF)};
            pg8::gemm_phase_m1ms(lds, P, G, (int)blockIdx.x, (l == DEPTH - 1) ? MLAT / 256 : MROWS / 256);
          }
        }
        SEAM(pb + 4);
        if (IN(pb + 5)) {
#pragma unroll 1
          for (int rep = 0; rep < ((l == 0) ? REP_M2L0 : 1); ++rep) {
            PlainProb P{(const char*)(ws + WS_NBUF), (const char*)(ws + WS_WOUT), DM * 2, DM * 2, DM};
            pg8::StaticOrder S; S.init((l == DEPTH - 1) ? MLAT / 256 : MROWS / 256, DM / 256, G, (int)blockIdx.x);
            EpiM2 E{l ? args.out : args.in[I_X], args.out, l ? (const float*)(ws + WS_HC) : args.in[I_CTX], (float*)(ws + WS_HC), (const float*)(ws + WS_MOD) + (size_t)l * 9 * 6144, (PROBE_GCHK && l == DEPTH - 1) ? (const unsigned*)(ws + WS_CTL) + 100 : nullptr};
            pg8::gemm_phase<PlainProb, EpiM2, true, true>(lds, P, S, E);
          }
          if (l + 1 < DEPTH) phase_convert(lds, args, l + 1, 0, CV_IN + CV_GT + CV_BR, (unsigned*)(ws + WS_CTL) + CW_CVQ + 64 * (2 * l + 1));
        }
        SEAM(pb + 5);
    }
#undef IN
#undef SEAM
}

#ifndef MK_SPLIT
#define MK_SPLIT 0
#endif
extern "C" void kernel_launch(void* const* d_in, const int* in_sizes, int n_in, void* d_out, int out_size, void* d_ws, size_t ws_size, hipStream_t stream) {
    static int grid = 0;
    if (grid == 0) {
        if (n_in != 21 || out_size != MLAT * DM || ws_size < WS_END) { fprintf(stderr, "kernel_launch: unexpected shapes (n_in %d out %d ws %zu)\n", n_in, out_size, ws_size); grid = -1; return; }
        int dev = 0, cus = 0, per_cu = 0;
        if (hipGetDevice(&dev) != hipSuccess || hipDeviceGetAttribute(&cus, hipDeviceAttributeMultiprocessorCount, dev) != hipSuccess) { grid = -1; return; }
        if (hipFuncSetAttribute((const void*)fwd_kernel, hipFuncAttributeMaxDynamicSharedMemorySize, LDS_BYTES) != hipSuccess) { fprintf(stderr, "kernel_launch: hipFuncSetAttribute failed\n"); grid = -1; return; }
        if (hipOccupancyMaxActiveBlocksPerMultiprocessor(&per_cu, (const void*)fwd_kernel, NTHR, LDS_BYTES) != hipSuccess || per_cu < 1) { fprintf(stderr, "kernel_launch: occupancy query says %d\n", per_cu); }
        (void)hipGetLastError();
        grid = cus;
    }
    if (grid < 0) return;
    if (hipMemsetAsync((char*)d_ws + WS_CTL, 0, CTL_ZERO_BYTES, stream) != hipSuccess) return;
    Args a{};
    for (int i = 0; i < 21; ++i) a.in[i] = (const float*)d_in[i];
    a.out = (float*)d_out; a.ws = (unsigned char*)d_ws;
#if MK_SPLIT
    for (int p = 0; p < NPHASE; ++p) { a.ph_lo = p; a.ph_hi = p + 1; hipLaunchKernelGGL(fwd_kernel, dim3(grid), dim3(NTHR), LDS_BYTES, stream, a); }
#else
    a.ph_lo = 0; a.ph_hi = NPHASE; hipLaunchKernelGGL(fwd_kernel, dim3(grid), dim3(NTHR), LDS_BYTES, stream, a);
#endif
}
```

```cpp
#include <hip/hip_runtime.h>
#include <cstdio>
#include <cstdint>

#define GAS __attribute__((address_space(1)))
#define LAS __attribute__((address_space(3)))
typedef unsigned short bf16;
typedef unsigned v4u __attribute__((ext_vector_type(4)));
typedef unsigned v2u __attribute__((ext_vector_type(2)));
typedef float f32x4 __attribute__((ext_vector_type(4)));
typedef float f32x2 __attribute__((ext_vector_type(2)));
typedef short bf16x8 __attribute__((ext_vector_type(8)));

namespace pg8 {
constexpr int BM = 256, BK = 64, HALF = 128, HTB = HALF * BK * 2  , STAGE_BYTES = 8 * HTB, NXCD = 8, WGM = 8;
__host__ __device__ __forceinline__ int lds_byte(int r, int c) { const int st = (r >> 4) * 2 + (c >> 5), rr = r & 15, cc = c & 31, ob = rr * 64 + cc * 2; return st * 1024 + (ob ^ (((ob >> 9) & 1) << 5)); }
__host__ __device__ __forceinline__ void stage_rc(int b, int& R, int& C) { const int st = b / 1024, sb = b % 1024, swz = sb ^ (((sb >> 9) & 1) << 5); R = (st >> 1) * 16 + swz / 64; C = (st & 1) * 32 + (swz % 64) / 2; }
__host__ __device__ __forceinline__ int perm32(int rho) { const int n = rho >> 4, i = rho & 15; return 8 * (i >> 2) + 4 * n + (i & 3); }

struct Unit { int pm, pn; };
struct StaticOrder {
    int nM, nN, nwg, G, c, wgm;
    __host__ __device__ __forceinline__ void init(int nM_, int nN_, int G_, int c_, int wgm_ = WGM) { nM = nM_; nN = nN_; nwg = nM * nN; G = G_; c = c_; wgm = wgm_; }
    __host__ __device__ __forceinline__ bool next(int i, Unit& u) const {
        const long L = (long)i * G + c; if (L >= nwg) return false;
        int wgid = (int)L; { const int q = nwg / NXCD, r = nwg % NXCD, xcd = wgid % NXCD, off = wgid / NXCD; wgid = (xcd < r ? xcd * (q + 1) : r * (q + 1) + (xcd - r) * q) + off; }
        const int nig = wgm * nN, gid = wgid / nig, fm = gid * wgm, gsz = (nM - fm) < wgm ? (nM - fm) : wgm;
        u.pm = fm + ((wgid % nig) % gsz); u.pn = (wgid % nig) / gsz; return true;
    }
};
typedef __bf16 bf16x2_n __attribute__((ext_vector_type(2)));
__device__ __forceinline__ unsigned cvt_pk_bf16(float lo, float hi) { f32x2 v; v.x = lo; v.y = hi; return __builtin_bit_cast(unsigned, __builtin_convertvector(v, bf16x2_n)); }

typedef int i32x4 __attribute__((ext_vector_type(4)));
template <bool I8> struct AccT { typedef f32x4 T; };
template <> struct AccT<true> { typedef i32x4 T; };
template <class Prob, class Epi, bool ALIGN_EPI, bool SP2, class Sched = StaticOrder, bool I8 = false>
__device__ __forceinline__ void gemm_phase(LAS unsigned char* lds, const Prob& P, const Sched& S, const Epi& E) {
    int tid_ = threadIdx.x; asm volatile("" : "+v"(tid_));
    const int tid = tid_, wid = __builtin_amdgcn_readfirstlane(tid >> 6), lane = tid & 63, wr = wid >> 2, wc = wid & 3, fr = lane & 15, fq = lane >> 4;
    const int nt = P.K / BK;
    unsigned voffA[2], voffB[2];
#pragma unroll
    for (int i = 0; i < 2; ++i) { int R, C; stage_rc(tid * 16 + i * 8192, R, C); const int Rb = Epi::PERM ? ((R & ~31) + perm32(R & 31)) : R;
        voffA[i] = (unsigned)R * P.lda + (unsigned)C * 2u; voffB[i] = (unsigned)Rb * P.ldb + (unsigned)C * 2u; }
    const size_t kstep = (size_t)(BK * 2);
    const size_t hstepA = (size_t)HALF * P.lda, hstepB = (size_t)HALF * P.ldb;
    const unsigned ldsw = (unsigned)wid * 1024u;
    const int aoff = lds_byte(wr * 64 + fr, fq * 8), boff = lds_byte(wc * 32 + fr, fq * 8);
#define PG8_SA(b, h) (((b) * 2 + (h)) * HTB)
#define PG8_SB(b, h) ((4 + (b) * 2 + (h)) * HTB)
#define PG8_STAGE(bufoff, gbase, voff) do { _Pragma("unroll") for (int _i = 0; _i < 2; ++_i) \
        __builtin_amdgcn_global_load_lds((const unsigned*)((const char*)(gbase) + (voff)[_i]), (LAS unsigned*)(lds + (bufoff) + ldsw + _i * 8192), 16, 0, 0); } while (0)
#define PG8_LDA(dst, b, h) do { _Pragma("unroll") for (int m = 0; m < 4; ++m) _Pragma("unroll") for (int k = 0; k < 2; ++k) dst[m][k] = *(const LAS bf16x8*)(lds + PG8_SA(b, h) + aoff + m * 2048 + k * 1024); } while (0)
#define PG8_LDB(dst, b, h) do { _Pragma("unroll") for (int n = 0; n < 2; ++n) _Pragma("unroll") for (int k = 0; k < 2; ++k) dst[n][k] = *(const LAS bf16x8*)(lds + PG8_SB(b, h) + boff + n * 2048 + k * 1024); } while (0)
#define PG8_MMA(ai, bj, At, Bt) do { __builtin_amdgcn_s_setprio(1); _Pragma("unroll") for (int m = 0; m < 4; ++m) _Pragma("unroll") for (int n = 0; n < 2; ++n) _Pragma("unroll") for (int k = 0; k < 2; ++k) { \
        if constexpr (I8) asm volatile("v_mfma_i32_16x16x64_i8 %0, %1, %2, %0" : "+v"(acc[ai][bj][m][n]) : "v"(Bt[n][k]), "v"(At[m][k]));   \
        else acc[ai][bj][m][n] = __builtin_amdgcn_mfma_f32_16x16x32_bf16(Bt[n][k], At[m][k], acc[ai][bj][m][n], 0, 0, 0); } __builtin_amdgcn_s_setprio(0); } while (0)
#define PG8_WAIT_V(n) asm volatile("s_waitcnt vmcnt(" #n ")" ::: "memory")
#define PG8_WAIT_L(n) asm volatile("s_waitcnt lgkmcnt(" #n ")" ::: "memory")
#define PG8_BAR __builtin_amdgcn_s_barrier()
#define PG8_SCHED __builtin_amdgcn_sched_barrier(0)
    typedef typename AccT<I8>::T ACC;
    Unit cur, nxt; int ui = 0;
    if (!S.next(0, cur)) return;
    ACC acc[2][2][4][2];
#pragma unroll
    for (int a = 0; a < 2; ++a)
#pragma unroll
        for (int b = 0; b < 2; ++b)
#pragma unroll
            for (int m = 0; m < 4; ++m)
#pragma unroll
                for (int n = 0; n < 2; ++n) acc[a][b][m][n] = (ACC){0, 0, 0, 0};
    bf16x8 At[4][2], B0[2][2], B1[2][2];
    const char* cA = P.a_ptr(cur); const char* cB = P.b_ptr(cur);
    if constexpr (SP2) {
        PG8_STAGE(PG8_SB(0, 0), cB, voffB); PG8_STAGE(PG8_SB(0, 1), cB + hstepB, voffB); PG8_STAGE(PG8_SA(0, 0), cA, voffA); PG8_STAGE(PG8_SA(0, 1), cA + hstepA, voffA);
        if (wr == 1) PG8_BAR;
        PG8_WAIT_V(2); PG8_BAR;
        PG8_STAGE(PG8_SB(1, 0), cB + kstep, voffB); PG8_STAGE(PG8_SA(1, 0), cA + kstep, voffA); PG8_STAGE(PG8_SB(1, 1), cB + hstepB + kstep, voffB);
        PG8_WAIT_V(6); PG8_BAR;
    } else {
        PG8_STAGE(PG8_SB(0, 0), cB, voffB); PG8_STAGE(PG8_SA(0, 0), cA, voffA); PG8_STAGE(PG8_SB(0, 1), cB + hstepB, voffB); PG8_STAGE(PG8_SA(0, 1), cA + hstepA, voffA);
        if (wr == 1) PG8_BAR;
        PG8_WAIT_V(4); PG8_BAR;
        PG8_STAGE(PG8_SB(1, 0), cB + kstep, voffB); PG8_STAGE(PG8_SA(1, 0), cA + kstep, voffA); PG8_STAGE(PG8_SB(1, 1), cB + hstepB + kstep, voffB);
        PG8_WAIT_V(6); PG8_BAR;
    }
    for (;;) {
        const bool has_next = S.next(ui + 1, nxt);
        const char* nA = has_next ? P.a_ptr(nxt) : cA; const char* nB = has_next ? P.b_ptr(nxt) : cB;
        for (int t = 0; t < nt; t += 2) {
            const bool last = (t == nt - 2);
            const char* a1 = cA + (size_t)(t + 1) * kstep;
            const char* a2 = last ? nA : cA + (size_t)(t + 2) * kstep; const char* b2 = last ? nB : cB + (size_t)(t + 2) * kstep;
            const char* a3 = a2 + kstep; const char* b3 = b2 + kstep;
            if constexpr (SP2) {
            PG8_LDB(B0, 0, 0); PG8_LDB(B1, 0, 1); PG8_SCHED; PG8_LDA(At, 0, 0); PG8_STAGE(PG8_SA(1, 1), a1 + hstepA, voffA);
            PG8_WAIT_V(8); PG8_WAIT_L(0); PG8_BAR; PG8_MMA(0, 0, At, B0); PG8_MMA(0, 1, At, B1); PG8_BAR; PG8_SCHED;
            PG8_LDA(At, 0, 1); PG8_STAGE(PG8_SB(0, 0), b2, voffB); PG8_STAGE(PG8_SB(0, 1), b2 + hstepB, voffB); PG8_STAGE(PG8_SA(0, 0), a2, voffA);
            PG8_WAIT_V(8); PG8_WAIT_L(0); PG8_BAR; PG8_MMA(1, 0, At, B0); PG8_MMA(1, 1, At, B1); PG8_BAR; PG8_SCHED;
            PG8_LDB(B0, 1, 0); PG8_LDB(B1, 1, 1); PG8_SCHED; PG8_LDA(At, 1, 0); PG8_STAGE(PG8_SA(0, 1), a2 + hstepA, voffA);
            PG8_WAIT_V(8); PG8_WAIT_L(0); PG8_BAR; PG8_MMA(0, 0, At, B0); PG8_MMA(0, 1, At, B1); PG8_BAR; PG8_SCHED;
            PG8_LDA(At, 1, 1); PG8_STAGE(PG8_SB(1, 0), b3, voffB); PG8_STAGE(PG8_SB(1, 1), b3 + hstepB, voffB); PG8_STAGE(PG8_SA(1, 0), a3, voffA);
            PG8_WAIT_V(8); PG8_WAIT_L(0); PG8_BAR; PG8_MMA(1, 0, At, B0); PG8_MMA(1, 1, At, B1); PG8_BAR; PG8_SCHED;
            } else {
            PG8_LDB(B0, 0, 0); PG8_SCHED; PG8_LDA(At, 0, 0); PG8_STAGE(PG8_SA(1, 1), a1 + hstepA, voffA);
            PG8_WAIT_L(8); PG8_BAR; PG8_WAIT_L(0); PG8_MMA(0, 0, At, B0); PG8_BAR; PG8_SCHED;
            PG8_LDB(B1, 0, 1); PG8_STAGE(PG8_SB(0, 0), b2, voffB);
            PG8_BAR; PG8_WAIT_L(0); PG8_MMA(0, 1, At, B1); PG8_BAR;
            PG8_LDA(At, 0, 1); PG8_STAGE(PG8_SA(0, 0), a2, voffA);
            PG8_BAR; PG8_WAIT_L(0); PG8_MMA(1, 0, At, B0); PG8_BAR; PG8_SCHED;
            PG8_STAGE(PG8_SB(0, 1), b2 + hstepB, voffB);
            PG8_WAIT_V(6); PG8_BAR; PG8_MMA(1, 1, At, B1); PG8_BAR;
            PG8_LDB(B0, 1, 0); PG8_SCHED; PG8_LDA(At, 1, 0); PG8_STAGE(PG8_SA(0, 1), a2 + hstepA, voffA);
            PG8_WAIT_L(8); PG8_BAR; PG8_WAIT_L(0); PG8_MMA(0, 0, At, B0); PG8_BAR; PG8_SCHED;
            PG8_LDB(B1, 1, 1); PG8_STAGE(PG8_SB(1, 0), b3, voffB);
            PG8_BAR; PG8_WAIT_L(0); PG8_MMA(0, 1, At, B1); PG8_BAR;
            PG8_LDA(At, 1, 1); PG8_STAGE(PG8_SA(1, 0), a3, voffA);
            PG8_BAR; PG8_WAIT_L(0); PG8_MMA(1, 0, At, B0); PG8_BAR; PG8_SCHED;
            PG8_STAGE(PG8_SB(1, 1), b3 + hstepB, voffB);
            PG8_WAIT_V(6); PG8_BAR; PG8_MMA(1, 1, At, B1); PG8_BAR;
            }
        }
        if constexpr (ALIGN_EPI) { if (wr == 0) PG8_BAR; }
        E(acc, cur, wr, wc, fr, fq);
        if (!has_next) break;
#pragma unroll
        for (int a = 0; a < 2; ++a)
#pragma unroll
            for (int b = 0; b < 2; ++b)
#pragma unroll
                for (int m = 0; m < 4; ++m)
#pragma unroll
                    for (int n = 0; n < 2; ++n) acc[a][b][m][n] = (ACC){0, 0, 0, 0};
        cur = nxt; cA = nA; cB = nB; ++ui;
        if constexpr (ALIGN_EPI) { if (wr == 1) PG8_BAR; }
    }
    PG8_WAIT_V(0);
    if constexpr (!ALIGN_EPI) { if (wr == 0) PG8_BAR; }
    PG8_BAR;
#undef PG8_SA
#undef PG8_SB
#undef PG8_STAGE
#undef PG8_LDA
#undef PG8_LDB
#undef PG8_MMA
#undef PG8_WAIT_V
#undef PG8_WAIT_L
#undef PG8_BAR
#undef PG8_SCHED
}
}

namespace pg8 {
struct M1Prob {
    const char* Zb; const char* Wb; const unsigned char* G; bf16* T;
    __device__ __forceinline__ const char* a_ptr(int pm, int b) const { const int yc = (b == 0) ? 0 : ((b == 1) ? 1536 : ((b == 2) ? 2816 : 3840)); return Zb + ((size_t)pm * 256 * 5888 + yc) * 2; }
    __device__ __forceinline__ const char* b_ptr(int pn, int b) const { return Wb + ((size_t)b * 2048 + (size_t)pn * 128) * 512 * 2; }
    __device__ __forceinline__ const char* a_ptr128(int pm, int b) const { const int yc = (b == 0) ? 0 : ((b == 1) ? 1536 : ((b == 2) ? 2816 : 3840)); return Zb + ((size_t)pm * 128 * 5888 + yc) * 2; }
    __device__ __forceinline__ const char* b_ptr256(int pn, int b) const { return Wb + ((size_t)b * 2048 + (size_t)pn * 256) * 512 * 2; }
};
__device__ __forceinline__ void gemm_phase_m1(LAS unsigned char* lds, const M1Prob& P, int G, int c, int npanels) {
    int tid_ = threadIdx.x; asm volatile("" : "+v"(tid_));
    const int tid = tid_, wid = __builtin_amdgcn_readfirstlane(tid >> 6), lane = tid & 63, wr = wid >> 2, wc = wid & 3, fr = lane & 15, fq = lane >> 4;
    constexpr int K = 512, nt = K / BK; constexpr unsigned lda = 5888 * 2, ldb = 512 * 2;
    unsigned voffA[2], voffB[2];
#pragma unroll
    for (int i = 0; i < 2; ++i) { int R, C; stage_rc(tid * 16 + i * 8192, R, C); const int Rb = (R & ~31) + perm32(R & 31);
        voffA[i] = (unsigned)R * lda + (unsigned)C * 2u; voffB[i] = (unsigned)Rb * ldb + (unsigned)C * 2u; }
    const size_t kstep = (size_t)(BK * 2);
    const size_t hstepA = (size_t)HALF * lda;
    const unsigned ldsw = (unsigned)wid * 1024u;
    const int aoff = lds_byte(wr * 64 + fr, fq * 8), boff = lds_byte(wc * 32 + fr, fq * 8);
#define PG8_SA(b, h) (((b) * 2 + (h)) * HTB)
#define PG8_SB(b) ((4 + (b) * 2) * HTB)
#define PG8_STAGE(bufoff, gbase, voff) do { _Pragma("unroll") for (int _i = 0; _i < 2; ++_i) \
        __builtin_amdgcn_global_load_lds((const unsigned*)((const char*)(gbase) + (voff)[_i]), (LAS unsigned*)(lds + (bufoff) + ldsw + _i * 8192), 16, 0, 0); } while (0)
#define PG8_LDA(dst, b, h) do { _Pragma("unroll") for (int m = 0; m < 4; ++m) _Pragma("unroll") for (int k = 0; k < 2; ++k) dst[m][k] = *(const LAS bf16x8*)(lds + PG8_SA(b, h) + aoff + m * 2048 + k * 1024); } while (0)
#define PG8_LDB(dst, b) do { _Pragma("unroll") for (int n = 0; n < 2; ++n) _Pragma("unroll") for (int k = 0; k < 2; ++k) dst[n][k] = *(const LAS bf16x8*)(lds + PG8_SB(b) + boff + n * 2048 + k * 1024); } while (0)
#define PG8_MMA(ai, At, Bt) do { __builtin_amdgcn_s_setprio(1); _Pragma("unroll") for (int m = 0; m < 4; ++m) _Pragma("unroll") for (int n = 0; n < 2; ++n) _Pragma("unroll") for (int k = 0; k < 2; ++k) \
        acc[ai][m][n] = __builtin_amdgcn_mfma_f32_16x16x32_bf16(Bt[n][k], At[m][k], acc[ai][m][n], 0, 0, 0); __builtin_amdgcn_s_setprio(0); } while (0)
#define PG8_WAIT_V(n) asm volatile("s_waitcnt vmcnt(" #n ")" ::: "memory")
#define PG8_WAIT_L(n) asm volatile("s_waitcnt lgkmcnt(" #n ")" ::: "memory")
#define PG8_BAR __builtin_amdgcn_s_barrier()
#define PG8_SCHED __builtin_amdgcn_sched_barrier(0)
    StaticOrder S; S.init(npanels, 16, G, c);
    Unit cur, nxt; int ui = 0;
    if (!S.next(0, cur)) return;
    f32x4 acc[2][4][2], tot[2][4][2];
#pragma unroll
    for (int a = 0; a < 2; ++a)
#pragma unroll
        for (int m = 0; m < 4; ++m)
#pragma unroll
            for (int n = 0; n < 2; ++n) { acc[a][m][n] = (f32x4){0.f, 0.f, 0.f, 0.f}; tot[a][m][n] = (f32x4){0.f, 0.f, 0.f, 0.f}; }
    bf16x8 At[4][2], B0[2][2];
    v2u gq[2][4];
    const char* cA = P.a_ptr(cur.pm, 0); const char* cB = P.b_ptr(cur.pn, 0);
    PG8_STAGE(PG8_SB(0), cB, voffB); PG8_STAGE(PG8_SA(0, 0), cA, voffA); PG8_STAGE(PG8_SA(0, 1), cA + hstepA, voffA);
    if (wr == 1) PG8_BAR;
    PG8_WAIT_V(2); PG8_BAR;
    PG8_STAGE(PG8_SB(1), cB + kstep, voffB); PG8_STAGE(PG8_SA(1, 0), cA + kstep, voffA);
    PG8_WAIT_V(4); PG8_BAR;
    for (;;) {
        const int b = ui & 3;
        bool has_next = true;
        if (b == 3) has_next = S.next((ui >> 2) + 1, nxt); else nxt = cur;
        const int nb = (b + 1) & 3;
        const char* nA = has_next ? P.a_ptr(nxt.pm, nb) : cA; const char* nB = has_next ? P.b_ptr(nxt.pn, nb) : cB;
#pragma unroll 1
        for (int t = 0; t < nt; t += 2) {
            const bool last = (t == nt - 2);
            const char* a1 = cA + (size_t)(t + 1) * kstep;
            const char* a2 = last ? nA : cA + (size_t)(t + 2) * kstep; const char* b2 = last ? nB : cB + (size_t)(t + 2) * kstep;
            const char* a3 = a2 + kstep; const char* b3 = b2 + kstep;
            if (t == 2) {
                const unsigned char* gp = P.G + (size_t)(cur.pm * 256 + wr * 64 + fr) * 8192 + b * 2048 + cur.pn * 128 + wc * 32 + 8 * fq;
#pragma unroll
                for (int ai = 0; ai < 2; ++ai)
#pragma unroll
                    for (int m = 0; m < 4; ++m) { const unsigned char* q = gp + (size_t)(ai * 128 + m * 16) * 8192; asm volatile("global_load_dwordx2 %0, %1, off" : "=v"(gq[ai][m]) : "v"(q) : "memory"); }
            }
            PG8_LDB(B0, 0); PG8_SCHED; PG8_LDA(At, 0, 0); PG8_STAGE(PG8_SA(1, 1), a1 + hstepA, voffA);
            PG8_WAIT_V(6); PG8_WAIT_L(0); PG8_BAR; PG8_MMA(0, At, B0); PG8_BAR; PG8_SCHED;
            PG8_LDA(At, 0, 1); PG8_STAGE(PG8_SB(0), b2, voffB); PG8_STAGE(PG8_SA(0, 0), a2, voffA);
            PG8_WAIT_V(6); PG8_WAIT_L(0); PG8_BAR; PG8_MMA(1, At, B0); PG8_BAR; PG8_SCHED;
            PG8_LDB(B0, 1); PG8_SCHED; PG8_LDA(At, 1, 0); PG8_STAGE(PG8_SA(0, 1), a2 + hstepA, voffA);
            PG8_WAIT_V(6); PG8_WAIT_L(0); PG8_BAR; PG8_MMA(0, At, B0); PG8_BAR; PG8_SCHED;
            PG8_LDA(At, 1, 1); PG8_STAGE(PG8_SB(1), b3, voffB); PG8_STAGE(PG8_SA(1, 0), a3, voffA);
            PG8_WAIT_V(6); PG8_WAIT_L(0); PG8_BAR; PG8_MMA(1, At, B0); PG8_BAR; PG8_SCHED;
        }
        if (wr == 0) PG8_BAR;
        {
            const int row0 = cur.pm * 256 + wr * 64 + fr, col = cur.pn * 128 + wc * 32 + 8 * fq;
#pragma unroll
            for (int ai = 0; ai < 2; ++ai)
#pragma unroll
                for (int m = 0; m < 4; ++m) { const size_t row = (size_t)(row0 + ai * 128 + m * 16);
#pragma unroll
                    for (int n = 0; n < 2; ++n) { const unsigned w = n ? gq[ai][m].y : gq[ai][m].x;
#pragma unroll
                        for (int j = 0; j < 4; ++j) { const float g = (float)((w >> (8 * j)) & 255u) * (1.0f / 255.0f); tot[ai][m][n][j] += g * acc[ai][m][n][j]; } }
                    if (b == 3) { v4u o; o.x = cvt_pk_bf16(tot[ai][m][0][0], tot[ai][m][0][1]); o.y = cvt_pk_bf16(tot[ai][m][0][2], tot[ai][m][0][3]); o.z = cvt_pk_bf16(tot[ai][m][1][0], tot[ai][m][1][1]); o.w = cvt_pk_bf16(tot[ai][m][1][2], tot[ai][m][1][3]);
                        *(v4u*)(P.T + row * 2048 + col) = o; tot[ai][m][0] = (f32x4){0.f, 0.f, 0.f, 0.f}; tot[ai][m][1] = (f32x4){0.f, 0.f, 0.f, 0.f}; }
                    acc[ai][m][0] = (f32x4){0.f, 0.f, 0.f, 0.f}; acc[ai][m][1] = (f32x4){0.f, 0.f, 0.f, 0.f}; }
        }
        if (!has_next) break;
        cur = nxt; cA = nA; cB = nB; ++ui;
        if (wr == 1) PG8_BAR;
    }
    PG8_WAIT_V(0);
    PG8_BAR;
#undef PG8_SA
#undef PG8_SB
#undef PG8_STAGE
#undef PG8_LDA
#undef PG8_LDB
#undef PG8_MMA
#undef PG8_WAIT_V
#undef PG8_WAIT_L
#undef PG8_BAR
#undef PG8_SCHED
}
__device__ __forceinline__ void gemm_phase_m1ms(LAS unsigned char* lds, const M1Prob& P, int G, int c, int npanels) {
    int tid_ = threadIdx.x; asm volatile("" : "+v"(tid_));
    const int tid = tid_, wid = __builtin_amdgcn_readfirstlane(tid >> 6), lane = tid & 63, wr = wid >> 2, wc = wid & 3, fr = lane & 15, fq = lane >> 4;
    constexpr int K = 512, nt = K / BK; constexpr unsigned lda = 5888 * 2, ldb = 512 * 2;
    unsigned voffA[2], voffB[2];
#pragma unroll
    for (int i = 0; i < 2; ++i) { int R, C; stage_rc(tid * 16 + i * 8192, R, C); const int Rb = (R & ~31) + perm32(R & 31);
        voffA[i] = (unsigned)R * lda + (unsigned)C * 2u; voffB[i] = (unsigned)Rb * ldb + (unsigned)C * 2u; }
    const size_t kstep = (size_t)(BK * 2);
    const size_t hstepB = (size_t)HALF * ldb;
    const unsigned ldsw = (unsigned)wid * 1024u;
    const int aoff = lds_byte(wr * 64 + fr, fq * 8), boff = lds_byte(wc * 32 + fr, fq * 8);
#define PG8_SA(b) (((b) * 2) * HTB)
#define PG8_SB(b, h) ((4 + (b) * 2 + (h)) * HTB)
#define PG8_STAGE(bufoff, gbase, voff) do { _Pragma("unroll") for (int _i = 0; _i < 2; ++_i) \
        __builtin_amdgcn_global_load_lds((const unsigned*)((const char*)(gbase) + (voff)[_i]), (LAS unsigned*)(lds + (bufoff) + ldsw + _i * 8192), 16, 0, 0); } while (0)
#define PG8_LDA(dst, b) do { _Pragma("unroll") for (int m = 0; m < 4; ++m) _Pragma("unroll") for (int k = 0; k < 2; ++k) dst[m][k] = *(const LAS bf16x8*)(lds + PG8_SA(b) + aoff + m * 2048 + k * 1024); } while (0)
#define PG8_LDB(dst, b, h) do { _Pragma("unroll") for (int n = 0; n < 2; ++n) _Pragma("unroll") for (int k = 0; k < 2; ++k) dst[n][k] = *(const LAS bf16x8*)(lds + PG8_SB(b, h) + boff + n * 2048 + k * 1024); } while (0)
#define PG8_MMA(ai, At, Bt) do { __builtin_amdgcn_s_setprio(1); _Pragma("unroll") for (int m = 0; m < 4; ++m) _Pragma("unroll") for (int n = 0; n < 2; ++n) _Pragma("unroll") for (int k = 0; k < 2; ++k) \
        acc[ai][m][n] = __builtin_amdgcn_mfma_f32_16x16x32_bf16(Bt[n][k], At[m][k], acc[ai][m][n], 0, 0, 0); __builtin_amdgcn_s_setprio(0); } while (0)
#define PG8_WAIT_V(n) asm volatile("s_waitcnt vmcnt(" #n ")" ::: "memory")
#define PG8_WAIT_L(n) asm volatile("s_waitcnt lgkmcnt(" #n ")" ::: "memory")
#define PG8_BAR __builtin_amdgcn_s_barrier()
#define PG8_SCHED __builtin_amdgcn_sched_barrier(0)
    StaticOrder S; S.init(npanels * 2, 8, G, c);
    Unit cur, nxt; int ui = 0;
    if (!S.next(0, cur)) return;
    f32x4 acc[2][4][2], tot[2][4][2];
#pragma unroll
    for (int a = 0; a < 2; ++a)
#pragma unroll
        for (int m = 0; m < 4; ++m)
#pragma unroll
            for (int n = 0; n < 2; ++n) { acc[a][m][n] = (f32x4){0.f, 0.f, 0.f, 0.f}; tot[a][m][n] = (f32x4){0.f, 0.f, 0.f, 0.f}; }
    bf16x8 At[4][2], B0[2][2];
    v2u gq[2][4];
    const char* cA = P.a_ptr128(cur.pm, 0); const char* cB = P.b_ptr256(cur.pn, 0);
    PG8_STAGE(PG8_SA(0), cA, voffA); PG8_STAGE(PG8_SB(0, 0), cB, voffB); PG8_STAGE(PG8_SB(0, 1), cB + hstepB, voffB);
    if (wr == 1) PG8_BAR;
    PG8_WAIT_V(2); PG8_BAR;
    PG8_STAGE(PG8_SA(1), cA + kstep, voffA); PG8_STAGE(PG8_SB(1, 0), cB + kstep, voffB);
    PG8_WAIT_V(4); PG8_BAR;
    for (;;) {
        const int b = ui & 3;
        bool has_next = true;
        if (b == 3) has_next = S.next((ui >> 2) + 1, nxt); else nxt = cur;
        const int nb = (b + 1) & 3;
        const char* nA = has_next ? P.a_ptr128(nxt.pm, nb) : cA; const char* nB = has_next ? P.b_ptr256(nxt.pn, nb) : cB;
#pragma unroll 1
        for (int t = 0; t < nt; t += 2) {
            const bool last = (t == nt - 2);
            const char* b1 = cB + (size_t)(t + 1) * kstep;
            const char* a2 = last ? nA : cA + (size_t)(t + 2) * kstep; const char* b2 = last ? nB : cB + (size_t)(t + 2) * kstep;
            const char* a3 = a2 + kstep; const char* b3 = b2 + kstep;
            if (t == 2) {
                const unsigned char* gp = P.G + (size_t)(cur.pm * 128 + wr * 64 + fr) * 8192 + b * 2048 + cur.pn * 256 + wc * 32 + 8 * fq;
#pragma unroll
                for (int ai = 0; ai < 2; ++ai)
#pragma unroll
                    for (int m = 0; m < 4; ++m) { const unsigned char* q = gp + (size_t)(m * 16) * 8192 + ai * 128; asm volatile("global_load_dwordx2 %0, %1, off" : "=v"(gq[ai][m]) : "v"(q) : "memory"); }
            }
            PG8_LDA(At, 0); PG8_SCHED; PG8_LDB(B0, 0, 0); PG8_STAGE(PG8_SB(1, 1), b1 + hstepB, voffB);
            PG8_WAIT_V(6); PG8_WAIT_L(0); PG8_BAR; PG8_MMA(0, At, B0); PG8_BAR; PG8_SCHED;
            PG8_LDB(B0, 0, 1); PG8_STAGE(PG8_SA(0), a2, voffA); PG8_STAGE(PG8_SB(0, 0), b2, voffB);
            PG8_WAIT_V(6); PG8_WAIT_L(0); PG8_BAR; PG8_MMA(1, At, B0); PG8_BAR; PG8_SCHED;
            PG8_LDA(At, 1); PG8_SCHED; PG8_LDB(B0, 1, 0); PG8_STAGE(PG8_SB(0, 1), b2 + hstepB, voffB);
            PG8_WAIT_V(6); PG8_WAIT_L(0); PG8_BAR; PG8_MMA(0, At, B0); PG8_BAR; PG8_SCHED;
            PG8_LDB(B0, 1, 1); PG8_STAGE(PG8_SA(1), a3, voffA); PG8_STAGE(PG8_SB(1, 0), b3, voffB);
            PG8_WAIT_V(6); PG8_WAIT_L(0); PG8_BAR; PG8_MMA(1, At, B0); PG8_BAR; PG8_SCHED;
        }
        if (wr == 0) PG8_BAR;
        {
            const int row0 = cur.pm * 128 + wr * 64 + fr, col0 = cur.pn * 256 + wc * 32 + 8 * fq;
#pragma unroll
            for (int ai = 0; ai < 2; ++ai)
#pragma unroll
                for (int m = 0; m < 4; ++m) { const size_t row = (size_t)(row0 + m * 16); const int col = col0 + ai * 128;
#pragma unroll
                    for (int n = 0; n < 2; ++n) { const unsigned w = n ? gq[ai][m].y : gq[ai][m].x;
#pragma unroll
                        for (int j = 0; j < 4; ++j) { const float g = (float)((w >> (8 * j)) & 255u) * (1.0f / 255.0f); tot[ai][m][n][j] += g * acc[ai][m][n][j]; } }
                    if (b == 3) { v4u o; o.x = cvt_pk_bf16(tot[ai][m][0][0], tot[ai][m][0][1]); o.y = cvt_pk_bf16(tot[ai][m][0][2], tot[ai][m][0][3]); o.z = cvt_pk_bf16(tot[ai][m][1][0], tot[ai][m][1][1]); o.w = cvt_pk_bf16(tot[ai][m][1][2], tot[ai][m][1][3]);
                        *(v4u*)(P.T + row * 2048 + col) = o; tot[ai][m][0] = (f32x4){0.f, 0.f, 0.f, 0.f}; tot[ai][m][1] = (f32x4){0.f, 0.f, 0.f, 0.f}; }
                    acc[ai][m][0] = (f32x4){0.f, 0.f, 0.f, 0.f}; acc[ai][m][1] = (f32x4){0.f, 0.f, 0.f, 0.f}; }
        }
        if (!has_next) break;
        cur = nxt; cA = nA; cB = nB; ++ui;
        if (wr == 1) PG8_BAR;
    }
    PG8_WAIT_V(0);
    PG8_BAR;
#undef PG8_SA
#undef PG8_SB
#undef PG8_STAGE
#undef PG8_LDA
#undef PG8_LDB
#undef PG8_MMA
#undef PG8_WAIT_V
#undef PG8_WAIT_L
#undef PG8_BAR
#undef PG8_SCHED
}
template <class Epi>
__device__ __forceinline__ void gemm_phase_half(LAS unsigned char* lds, const char* cA, const char* cB, unsigned lda, unsigned ldb, int K, bool active, const Epi& E, int rowbase, int pn) {
    int tid_ = threadIdx.x; asm volatile("" : "+v"(tid_));
    const int tid = tid_, wid = __builtin_amdgcn_readfirstlane(tid >> 6), lane = tid & 63, wr = wid >> 2, wc = wid & 3, fr = lane & 15, fq = lane >> 4;
    if (!active) return;
    const int nt = K / BK;
    unsigned voffA[2], voffB[2];
#pragma unroll
    for (int i = 0; i < 2; ++i) { int R, C; stage_rc(tid * 16 + i * 8192, R, C); const int Rb = Epi::PERM ? ((R & ~31) + perm32(R & 31)) : R;
        voffA[i] = (unsigned)R * lda + (unsigned)C * 2u; voffB[i] = (unsigned)Rb * ldb + (unsigned)C * 2u; }
    const size_t kstep = (size_t)(BK * 2);
    const size_t hstepB = (size_t)HALF * ldb;
    const unsigned ldsw = (unsigned)wid * 1024u;
    const int aoff = lds_byte(wr * 64 + fr, fq * 8), boff = lds_byte(wc * 32 + fr, fq * 8);
#define PG8_SA(b) (((b) * 2) * HTB)
#define PG8_SB(b, h) ((4 + (b) * 2 + (h)) * HTB)
#define PG8_STAGE(bufoff, gbase, voff) do { _Pragma("unroll") for (int _i = 0; _i < 2; ++_i) \
        __builtin_amdgcn_global_load_lds((const unsigned*)((const char*)(gbase) + (voff)[_i]), (LAS unsigned*)(lds + (bufoff) + ldsw + _i * 8192), 16, 0, 0); } while (0)
#define PG8_LDA(dst, b) do { _Pragma("unroll") for (int m = 0; m < 4; ++m) _Pragma("unroll") for (int k = 0; k < 2; ++k) dst[m][k] = *(const LAS bf16x8*)(lds + PG8_SA(b) + aoff + m * 2048 + k * 1024); } while (0)
#define PG8_LDB(dst, b, h) do { _Pragma("unroll") for (int n = 0; n < 2; ++n) _Pragma("unroll") for (int k = 0; k < 2; ++k) dst[n][k] = *(const LAS bf16x8*)(lds + PG8_SB(b, h) + boff + n * 2048 + k * 1024); } while (0)
#define PG8_MMA(ai, At, Bt) do { __builtin_amdgcn_s_setprio(1); _Pragma("unroll") for (int m = 0; m < 4; ++m) _Pragma("unroll") for (int n = 0; n < 2; ++n) _Pragma("unroll") for (int k = 0; k < 2; ++k) \
        acc[0][ai][m][n] = __builtin_amdgcn_mfma_f32_16x16x32_bf16(Bt[n][k], At[m][k], acc[0][ai][m][n], 0, 0, 0); __builtin_amdgcn_s_setprio(0); } while (0)
#define PG8_WAIT_V(n) asm volatile("s_waitcnt vmcnt(" #n ")" ::: "memory")
#define PG8_WAIT_L(n) asm volatile("s_waitcnt lgkmcnt(" #n ")" ::: "memory")
#define PG8_BAR __builtin_amdgcn_s_barrier()
#define PG8_SCHED __builtin_amdgcn_sched_barrier(0)
    f32x4 acc[1][2][4][2];
#pragma unroll
    for (int a = 0; a < 2; ++a)
#pragma unroll
        for (int m = 0; m < 4; ++m)
#pragma unroll
            for (int n = 0; n < 2; ++n) acc[0][a][m][n] = (f32x4){0.f, 0.f, 0.f, 0.f};
    bf16x8 At[4][2], B0[2][2];
    PG8_STAGE(PG8_SA(0), cA, voffA); PG8_STAGE(PG8_SB(0, 0), cB, voffB); PG8_STAGE(PG8_SB(0, 1), cB + hstepB, voffB);
    if (wr == 1) PG8_BAR;
    PG8_WAIT_V(2); PG8_BAR;
    PG8_STAGE(PG8_SA(1), cA + kstep, voffA); PG8_STAGE(PG8_SB(1, 0), cB + kstep, voffB);
    PG8_WAIT_V(4); PG8_BAR;
#pragma unroll 1
    for (int t = 0; t < nt; t += 2) {
        const bool last = (t == nt - 2);
        const char* b1 = cB + (size_t)(t + 1) * kstep;
        const char* a2 = last ? cA : cA + (size_t)(t + 2) * kstep; const char* b2 = last ? cB : cB + (size_t)(t + 2) * kstep;
        const char* a3 = a2 + kstep; const char* b3 = b2 + kstep;
        PG8_LDA(At, 0); PG8_SCHED; PG8_LDB(B0, 0, 0); PG8_STAGE(PG8_SB(1, 1), b1 + hstepB, voffB);
        PG8_WAIT_V(6); PG8_WAIT_L(0); PG8_BAR; PG8_MMA(0, At, B0); PG8_BAR; PG8_SCHED;
        PG8_LDB(B0, 0, 1); PG8_STAGE(PG8_SA(0), a2, voffA); PG8_STAGE(PG8_SB(0, 0), b2, voffB);
        PG8_WAIT_V(6); PG8_WAIT_L(0); PG8_BAR; PG8_MMA(1, At, B0); PG8_BAR; PG8_SCHED;
        PG8_LDA(At, 1); PG8_SCHED; PG8_LDB(B0, 1, 0); PG8_STAGE(PG8_SB(0, 1), b2 + hstepB, voffB);
        PG8_WAIT_V(6); PG8_WAIT_L(0); PG8_BAR; PG8_MMA(0, At, B0); PG8_BAR; PG8_SCHED;
        PG8_LDB(B0, 1, 1); PG8_STAGE(PG8_SA(1), a3, voffA); PG8_STAGE(PG8_SB(1, 0), b3, voffB);
        PG8_WAIT_V(6); PG8_WAIT_L(0); PG8_BAR; PG8_MMA(1, At, B0); PG8_BAR; PG8_SCHED;
    }
    if (wr == 0) PG8_BAR;
    E.template run<1>(acc, rowbase, pn, wr, wc, fr, fq);
    PG8_WAIT_V(0);
    PG8_BAR;
#undef PG8_SA
#undef PG8_SB
#undef PG8_STAGE
#undef PG8_LDA
#undef PG8_LDB
#undef PG8_MMA
#undef PG8_WAIT_V
#undef PG8_WAIT_L
#undef PG8_BAR
#undef PG8_SCHED
}
struct C2Prob {
    const char* cs; const char* sn; const char* fc; const char* fs; const float* uch; bf16* Z; float scale;
    __device__ __forceinline__ const char* a_ptr(int pm, int sub) const { return (sub ? sn : cs) + (size_t)(pm & 7) * 256 * 2048 * 2; }
    __device__ __forceinline__ const char* b_ptr(int pm, int pn, int sub) const { return (sub ? fs : fc) + ((size_t)(pm >> 3) * 512 + (size_t)pn * 128) * 2048 * 2; }
};
__device__ __forceinline__ void gemm_phase_c2(LAS unsigned char* lds, const C2Prob& P, int G, int c) {
    int tid_ = threadIdx.x; asm volatile("" : "+v"(tid_));
    const int tid = tid_, wid = __builtin_amdgcn_readfirstlane(tid >> 6), lane = tid & 63, wr = wid >> 2, wc = wid & 3, fr = lane & 15, fq = lane >> 4;
    constexpr int K = 2048, nt = K / BK; constexpr unsigned lda = 2048 * 2, ldb = 2048 * 2;
    unsigned voffA[2], voffB[2];
#pragma unroll
    for (int i = 0; i < 2; ++i) { int R, C; stage_rc(tid * 16 + i * 8192, R, C); const int Rb = (R & ~31) + perm32(R & 31);
        voffA[i] = (unsigned)R * lda + (unsigned)C * 2u; voffB[i] = (unsigned)Rb * ldb + (unsigned)C * 2u; }
    const size_t kstep = (size_t)(BK * 2);
    const size_t hstepA = (size_t)HALF * lda;
    const unsigned ldsw = (unsigned)wid * 1024u;
    const int aoff = lds_byte(wr * 64 + fr, fq * 8), boff = lds_byte(wc * 32 + fr, fq * 8);
#define PG8_SA(b, h) (((b) * 2 + (h)) * HTB)
#define PG8_SB(b) ((4 + (b) * 2) * HTB)
#define PG8_STAGE(bufoff, gbase, voff) do { _Pragma("unroll") for (int _i = 0; _i < 2; ++_i) \
        __builtin_amdgcn_global_load_lds((const unsigned*)((const char*)(gbase) + (voff)[_i]), (LAS unsigned*)(lds + (bufoff) + ldsw + _i * 8192), 16, 0, 0); } while (0)
#define PG8_LDA(dst, b, h) do { _Pragma("unroll") for (int m = 0; m < 4; ++m) _Pragma("unroll") for (int k = 0; k < 2; ++k) dst[m][k] = *(const LAS bf16x8*)(lds + PG8_SA(b, h) + aoff + m * 2048 + k * 1024); } while (0)
#define PG8_LDB(dst, b) do { _Pragma("unroll") for (int n = 0; n < 2; ++n) _Pragma("unroll") for (int k = 0; k < 2; ++k) dst[n][k] = *(const LAS bf16x8*)(lds + PG8_SB(b) + boff + n * 2048 + k * 1024); } while (0)
#define PG8_MMA(ai, At, Bt) do { __builtin_amdgcn_s_setprio(1); _Pragma("unroll") for (int m = 0; m < 4; ++m) _Pragma("unroll") for (int n = 0; n < 2; ++n) _Pragma("unroll") for (int k = 0; k < 2; ++k) \
        acc[ai][m][n] = __builtin_amdgcn_mfma_f32_16x16x32_bf16(Bt[n][k], At[m][k], acc[ai][m][n], 0, 0, 0); __builtin_amdgcn_s_setprio(0); } while (0)
#define PG8_WAIT_V(n) asm volatile("s_waitcnt vmcnt(" #n ")" ::: "memory")
#define PG8_WAIT_L(n) asm volatile("s_waitcnt lgkmcnt(" #n ")" ::: "memory")
#define PG8_BAR __builtin_amdgcn_s_barrier()
#define PG8_SCHED __builtin_amdgcn_sched_barrier(0)
    StaticOrder S; S.init(64, 4, G, c);
    Unit cur, nxt; int ui = 0;
    if (!S.next(0, cur)) return;
    f32x4 acc[2][4][2], tot[2][4][2];
#pragma unroll
    for (int a = 0; a < 2; ++a)
#pragma unroll
        for (int m = 0; m < 4; ++m)
#pragma unroll
            for (int n = 0; n < 2; ++n) { acc[a][m][n] = (f32x4){0.f, 0.f, 0.f, 0.f}; tot[a][m][n] = (f32x4){0.f, 0.f, 0.f, 0.f}; }
    bf16x8 At[4][2], B0[2][2];
    const char* cA = P.a_ptr(cur.pm, 0); const char* cB = P.b_ptr(cur.pm, cur.pn, 0);
    PG8_STAGE(PG8_SB(0), cB, voffB); PG8_STAGE(PG8_SA(0, 0), cA, voffA); PG8_STAGE(PG8_SA(0, 1), cA + hstepA, voffA);
    if (wr == 1) PG8_BAR;
    PG8_WAIT_V(2); PG8_BAR;
    PG8_STAGE(PG8_SB(1), cB + kstep, voffB); PG8_STAGE(PG8_SA(1, 0), cA + kstep, voffA);
    PG8_WAIT_V(4); PG8_BAR;
    for (;;) {
        const int b = ui & 1;
        bool has_next = true;
        if (b == 1) has_next = S.next((ui >> 1) + 1, nxt); else nxt = cur;
        const int nb = (b + 1) & 1;
        const char* nA = has_next ? P.a_ptr(nxt.pm, nb) : cA; const char* nB = has_next ? P.b_ptr(nxt.pm, nxt.pn, nb) : cB;
#pragma unroll 1
        for (int t = 0; t < nt; t += 2) {
            const bool last = (t == nt - 2);
            const char* a1 = cA + (size_t)(t + 1) * kstep;
            const char* a2 = last ? nA : cA + (size_t)(t + 2) * kstep; const char* b2 = last ? nB : cB + (size_t)(t + 2) * kstep;
            const char* a3 = a2 + kstep; const char* b3 = b2 + kstep;
            PG8_LDB(B0, 0); PG8_SCHED; PG8_LDA(At, 0, 0); PG8_STAGE(PG8_SA(1, 1), a1 + hstepA, voffA);
            PG8_WAIT_V(6); PG8_WAIT_L(0); PG8_BAR; PG8_MMA(0, At, B0); PG8_BAR; PG8_SCHED;
            PG8_LDA(At, 0, 1); PG8_STAGE(PG8_SB(0), b2, voffB); PG8_STAGE(PG8_SA(0, 0), a2, voffA);
            PG8_WAIT_V(6); PG8_WAIT_L(0); PG8_BAR; PG8_MMA(1, At, B0); PG8_BAR; PG8_SCHED;
            PG8_LDB(B0, 1); PG8_SCHED; PG8_LDA(At, 1, 0); PG8_STAGE(PG8_SA(0, 1), a2 + hstepA, voffA);
            PG8_WAIT_V(6); PG8_WAIT_L(0); PG8_BAR; PG8_MMA(0, At, B0); PG8_BAR; PG8_SCHED;
            PG8_LDA(At, 1, 1); PG8_STAGE(PG8_SB(1), b3, voffB); PG8_STAGE(PG8_SA(1, 0), a3, voffA);
            PG8_WAIT_V(6); PG8_WAIT_L(0); PG8_BAR; PG8_MMA(1, At, B0); PG8_BAR; PG8_SCHED;
        }
        if (wr == 0) PG8_BAR;
        if (b == 0) {
#pragma unroll
            for (int ai = 0; ai < 2; ++ai)
#pragma unroll
                for (int m = 0; m < 4; ++m)
#pragma unroll
                    for (int n = 0; n < 2; ++n) { tot[ai][m][n] = acc[ai][m][n]; acc[ai][m][n] = (f32x4){0.f, 0.f, 0.f, 0.f}; }
        } else {
            const int bb = cur.pm >> 3, k0 = (cur.pm & 7) * 256 + wr * 64 + fr, d0 = cur.pn * 128 + wc * 32 + 8 * fq;
            const f32x4 e0 = *(const f32x4*)(P.uch + bb * 512 + d0), e1 = *(const f32x4*)(P.uch + bb * 512 + d0 + 4);
#pragma unroll
            for (int ai = 0; ai < 2; ++ai) {
                v4u zpa[4], zma[4];
#pragma unroll
                for (int m = 0; m < 4; ++m) { const int k = k0 + ai * 128 + m * 16;
                    zpa[m] = *(const v4u*)(P.Z + ((size_t)bb * 4096 + k) * 5888 + 3328 + d0); zma[m] = *(const v4u*)(P.Z + ((size_t)bb * 4096 + ((4096 - k) & 4095)) * 5888 + 3328 + d0); }
                __builtin_amdgcn_sched_barrier(0);
#pragma unroll
                for (int m = 0; m < 4; ++m) { const int k = k0 + ai * 128 + m * 16; const float sg = (k & 1) ? -P.scale : P.scale;
                    bf16* rp = P.Z + ((size_t)bb * 4096 + k) * 5888; bf16* rm = P.Z + ((size_t)bb * 4096 + ((4096 - k) & 4095)) * 5888;
                    const v4u zp = zpa[m], zm = zma[m];
                    float fp[8], fm[8], op[8], om[8];
                    fp[0] = __builtin_bit_cast(float, zp.x << 16); fp[1] = __builtin_bit_cast(float, zp.x & 0xffff0000u); fp[2] = __builtin_bit_cast(float, zp.y << 16); fp[3] = __builtin_bit_cast(float, zp.y & 0xffff0000u);
                    fp[4] = __builtin_bit_cast(float, zp.z << 16); fp[5] = __builtin_bit_cast(float, zp.z & 0xffff0000u); fp[6] = __builtin_bit_cast(float, zp.w << 16); fp[7] = __builtin_bit_cast(float, zp.w & 0xffff0000u);
                    fm[0] = __builtin_bit_cast(float, zm.x << 16); fm[1] = __builtin_bit_cast(float, zm.x & 0xffff0000u); fm[2] = __builtin_bit_cast(float, zm.y << 16); fm[3] = __builtin_bit_cast(float, zm.y & 0xffff0000u);
                    fm[4] = __builtin_bit_cast(float, zm.z << 16); fm[5] = __builtin_bit_cast(float, zm.z & 0xffff0000u); fm[6] = __builtin_bit_cast(float, zm.w << 16); fm[7] = __builtin_bit_cast(float, zm.w & 0xffff0000u);
#pragma unroll
                    for (int i = 0; i < 8; ++i) { const float ec = tot[ai][m][i >> 2][i & 3] * P.scale + sg * ((i < 4) ? e0[i & 3] : e1[i & 3]); const float es = acc[ai][m][i >> 2][i & 3] * P.scale;
                        op[i] = (ec + es) * fp[i]; om[i] = (ec - es) * fm[i]; }
                    v4u w; w.x = cvt_pk_bf16(op[0], op[1]); w.y = cvt_pk_bf16(op[2], op[3]); w.z = cvt_pk_bf16(op[4], op[5]); w.w = cvt_pk_bf16(op[6], op[7]);
                    *(v4u*)(rp + 2816 + d0) = w;
                    if (k != 0) { v4u x; x.x = cvt_pk_bf16(om[0], om[1]); x.y = cvt_pk_bf16(om[2], om[3]); x.z = cvt_pk_bf16(om[4], om[5]); x.w = cvt_pk_bf16(om[6], om[7]); *(v4u*)(rm + 2816 + d0) = x; }
                    acc[ai][m][0] = (f32x4){0.f, 0.f, 0.f, 0.f}; acc[ai][m][1] = (f32x4){0.f, 0.f, 0.f, 0.f}; }
                __builtin_amdgcn_sched_barrier(0);
            }
        }
        if (!has_next) break;
        cur = nxt; cA = nA; cB = nB; ++ui;
        if (wr == 1) PG8_BAR;
    }
    PG8_WAIT_V(0);
    PG8_BAR;
#undef PG8_SA
#undef PG8_SB
#undef PG8_STAGE
#undef PG8_LDA
#undef PG8_LDB
#undef PG8_MMA
#undef PG8_WAIT_V
#undef PG8_WAIT_L
#undef PG8_BAR
#undef PG8_SCHED
}
__device__ __forceinline__ void gemm_phase_m1x(LAS unsigned char* lds, const M1Prob& P, int G, int c, int npanels) {
    constexpr bool ALIGN_EPI = true, SP2 = true;
    int tid_ = threadIdx.x; asm volatile("" : "+v"(tid_));
    const int tid = tid_, wid = __builtin_amdgcn_readfirstlane(tid >> 6), lane = tid & 63, wr = wid >> 2, wc = wid & 3, fr = lane & 15, fq = lane >> 4;
    constexpr int nt = 512 / BK; struct { unsigned lda, ldb; } PP{5888u * 2u, 512u * 2u};
    unsigned voffA[2], voffB[2];
#pragma unroll
    for (int i = 0; i < 2; ++i) { int R, C; stage_rc(tid * 16 + i * 8192, R, C); const int Rb = (R & ~31) + perm32(R & 31);
        voffA[i] = (unsigned)R * PP.lda + (unsigned)C * 2u; voffB[i] = (unsigned)Rb * PP.ldb + (unsigned)C * 2u; }
    const size_t kstep = (size_t)(BK * 2);
    const size_t hstepA = (size_t)HALF * PP.lda, hstepB = (size_t)HALF * PP.ldb;
    const unsigned ldsw = (unsigned)wid * 1024u;
    const int aoff = lds_byte(wr * 64 + fr, fq * 8), boff = lds_byte(wc * 32 + fr, fq * 8);
#define PG8_SA(b, h) (((b) * 2 + (h)) * HTB)
#define PG8_SB(b, h) ((4 + (b) * 2 + (h)) * HTB)
#define PG8_STAGE(bufoff, gbase, voff) do { _Pragma("unroll") for (int _i = 0; _i < 2; ++_i) \
        __builtin_amdgcn_global_load_lds((const unsigned*)((const char*)(gbase) + (voff)[_i]), (LAS unsigned*)(lds + (bufoff) + ldsw + _i * 8192), 16, 0, 0); } while (0)
#define PG8_LDA(dst, b, h) do { _Pragma("unroll") for (int m = 0; m < 4; ++m) _Pragma("unroll") for (int k = 0; k < 2; ++k) dst[m][k] = *(const LAS bf16x8*)(lds + PG8_SA(b, h) + aoff + m * 2048 + k * 1024); } while (0)
#define PG8_LDB(dst, b, h) do { _Pragma("unroll") for (int n = 0; n < 2; ++n) _Pragma("unroll") for (int k = 0; k < 2; ++k) dst[n][k] = *(const LAS bf16x8*)(lds + PG8_SB(b, h) + boff + n * 2048 + k * 1024); } while (0)
#define PG8_MMA(ai, bj, At, Bt) do { __builtin_amdgcn_s_setprio(1); _Pragma("unroll") for (int m = 0; m < 4; ++m) _Pragma("unroll") for (int n = 0; n < 2; ++n) _Pragma("unroll") for (int k = 0; k < 2; ++k) { \
        acc[ai][bj][m][n] = __builtin_amdgcn_mfma_f32_16x16x32_bf16(Bt[n][k], At[m][k], acc[ai][bj][m][n], 0, 0, 0); } __builtin_amdgcn_s_setprio(0); } while (0)
#define PG8_WAIT_V(n) asm volatile("s_waitcnt vmcnt(" #n ")" ::: "memory")
#define PG8_WAIT_L(n) asm volatile("s_waitcnt lgkmcnt(" #n ")" ::: "memory")
#define PG8_BAR __builtin_amdgcn_s_barrier()
#define PG8_SCHED __builtin_amdgcn_sched_barrier(0)
    typedef f32x4 ACC;
    StaticOrder S; S.init(npanels, 8, G, c);
    Unit cur, nxt; int ui = 0;
    if (!S.next(0, cur)) return;
    ACC acc[2][2][4][2];
#pragma unroll
    for (int a = 0; a < 2; ++a)
#pragma unroll
        for (int b = 0; b < 2; ++b)
#pragma unroll
            for (int m = 0; m < 4; ++m)
#pragma unroll
                for (int n = 0; n < 2; ++n) acc[a][b][m][n] = (ACC){0, 0, 0, 0};
    bf16x8 At[4][2], B0[2][2], B1[2][2];
    const char* cA = P.a_ptr(cur.pm, 0); const char* cB = P.b_ptr256(cur.pn, 0);
    if constexpr (SP2) {
        PG8_STAGE(PG8_SB(0, 0), cB, voffB); PG8_STAGE(PG8_SB(0, 1), cB + hstepB, voffB); PG8_STAGE(PG8_SA(0, 0), cA, voffA); PG8_STAGE(PG8_SA(0, 1), cA + hstepA, voffA);
        if (wr == 1) PG8_BAR;
        PG8_WAIT_V(2); PG8_BAR;
        PG8_STAGE(PG8_SB(1, 0), cB + kstep, voffB); PG8_STAGE(PG8_SA(1, 0), cA + kstep, voffA); PG8_STAGE(PG8_SB(1, 1), cB + hstepB + kstep, voffB);
        PG8_WAIT_V(6); PG8_BAR;
    } else {
        PG8_STAGE(PG8_SB(0, 0), cB, voffB); PG8_STAGE(PG8_SA(0, 0), cA, voffA); PG8_STAGE(PG8_SB(0, 1), cB + hstepB, voffB); PG8_STAGE(PG8_SA(0, 1), cA + hstepA, voffA);
        if (wr == 1) PG8_BAR;
        PG8_WAIT_V(4); PG8_BAR;
        PG8_STAGE(PG8_SB(1, 0), cB + kstep, voffB); PG8_STAGE(PG8_SA(1, 0), cA + kstep, voffA); PG8_STAGE(PG8_SB(1, 1), cB + hstepB + kstep, voffB);
        PG8_WAIT_V(6); PG8_BAR;
    }
    for (;;) {
        const int b = ui & 3;
        bool has_next = true;
        if (b == 3) has_next = S.next((ui >> 2) + 1, nxt); else nxt = cur;
        const int nb = (b + 1) & 3;
        const char* nA = has_next ? P.a_ptr(nxt.pm, nb) : cA; const char* nB = has_next ? P.b_ptr256(nxt.pn, nb) : cB;
#pragma unroll 1
        for (int t = 0; t < nt; t += 2) {
            const bool last = (t == nt - 2);
            const char* a1 = cA + (size_t)(t + 1) * kstep;
            const char* a2 = last ? nA : cA + (size_t)(t + 2) * kstep; const char* b2 = last ? nB : cB + (size_t)(t + 2) * kstep;
            const char* a3 = a2 + kstep; const char* b3 = b2 + kstep;
            if constexpr (SP2) {
            PG8_LDB(B0, 0, 0); PG8_LDB(B1, 0, 1); PG8_SCHED; PG8_LDA(At, 0, 0); PG8_STAGE(PG8_SA(1, 1), a1 + hstepA, voffA);
            PG8_WAIT_V(8); PG8_WAIT_L(0); PG8_BAR; PG8_MMA(0, 0, At, B0); PG8_MMA(0, 1, At, B1); PG8_BAR; PG8_SCHED;
            PG8_LDA(At, 0, 1); PG8_STAGE(PG8_SB(0, 0), b2, voffB); PG8_STAGE(PG8_SB(0, 1), b2 + hstepB, voffB); PG8_STAGE(PG8_SA(0, 0), a2, voffA);
            PG8_WAIT_V(8); PG8_WAIT_L(0); PG8_BAR; PG8_MMA(1, 0, At, B0); PG8_MMA(1, 1, At, B1); PG8_BAR; PG8_SCHED;
            PG8_LDB(B0, 1, 0); PG8_LDB(B1, 1, 1); PG8_SCHED; PG8_LDA(At, 1, 0); PG8_STAGE(PG8_SA(0, 1), a2 + hstepA, voffA);
            PG8_WAIT_V(8); PG8_WAIT_L(0); PG8_BAR; PG8_MMA(0, 0, At, B0); PG8_MMA(0, 1, At, B1); PG8_BAR; PG8_SCHED;
            PG8_LDA(At, 1, 1); PG8_STAGE(PG8_SB(1, 0), b3, voffB); PG8_STAGE(PG8_SB(1, 1), b3 + hstepB, voffB); PG8_STAGE(PG8_SA(1, 0), a3, voffA);
            PG8_WAIT_V(8); PG8_WAIT_L(0); PG8_BAR; PG8_MMA(1, 0, At, B0); PG8_MMA(1, 1, At, B1); PG8_BAR; PG8_SCHED;
            } else {
            PG8_LDB(B0, 0, 0); PG8_SCHED; PG8_LDA(At, 0, 0); PG8_STAGE(PG8_SA(1, 1), a1 + hstepA, voffA);
            PG8_WAIT_L(8); PG8_BAR; PG8_WAIT_L(0); PG8_MMA(0, 0, At, B0); PG8_BAR; PG8_SCHED;
            PG8_LDB(B1, 0, 1); PG8_STAGE(PG8_SB(0, 0), b2, voffB);
            PG8_BAR; PG8_WAIT_L(0); PG8_MMA(0, 1, At, B1); PG8_BAR;
            PG8_LDA(At, 0, 1); PG8_STAGE(PG8_SA(0, 0), a2, voffA);
            PG8_BAR; PG8_WAIT_L(0); PG8_MMA(1, 0, At, B0); PG8_BAR; PG8_SCHED;
            PG8_STAGE(PG8_SB(0, 1), b2 + hstepB, voffB);
            PG8_WAIT_V(6); PG8_BAR; PG8_MMA(1, 1, At, B1); PG8_BAR;
            PG8_LDB(B0, 1, 0); PG8_SCHED; PG8_LDA(At, 1, 0); PG8_STAGE(PG8_SA(0, 1), a2 + hstepA, voffA);
            PG8_WAIT_L(8); PG8_BAR; PG8_WAIT_L(0); PG8_MMA(0, 0, At, B0); PG8_BAR; PG8_SCHED;
            PG8_LDB(B1, 1, 1); PG8_STAGE(PG8_SB(1, 0), b3, voffB);
            PG8_BAR; PG8_WAIT_L(0); PG8_MMA(0, 1, At, B1); PG8_BAR;
            PG8_LDA(At, 1, 1); PG8_STAGE(PG8_SA(1, 0), a3, voffA);
            PG8_BAR; PG8_WAIT_L(0); PG8_MMA(1, 0, At, B0); PG8_BAR; PG8_SCHED;
            PG8_STAGE(PG8_SB(1, 1), b3 + hstepB, voffB);
            PG8_WAIT_V(6); PG8_BAR; PG8_MMA(1, 1, At, B1); PG8_BAR;
            }
        }
        if (wr == 0) PG8_BAR;
        {
            const int row0 = cur.pm * 256 + wr * 64 + fr, col0 = cur.pn * 256 + wc * 32 + 8 * fq;
            const unsigned char* gp = P.G + (size_t)row0 * 8192 + b * 2048 + col0;
#pragma unroll
            for (int ai = 0; ai < 2; ++ai) {
                v2u ga[4][2], gb[4][2];
#pragma unroll
                for (int m = 0; m < 4; ++m)
#pragma unroll
                    for (int bj = 0; bj < 2; ++bj) { const unsigned char* q = gp + (size_t)(ai * 128 + m * 16) * 8192 + bj * 128; ga[m][bj] = *(const v2u*)q; gb[m][bj] = (b < 3) ? *(const v2u*)(q + 2048) : ga[m][bj]; }
                __builtin_amdgcn_sched_barrier(0);
#pragma unroll
                for (int m = 0; m < 4; ++m)
#pragma unroll
                    for (int bj = 0; bj < 2; ++bj) {
                        float f[8];
#pragma unroll
                        for (int i = 0; i < 8; ++i) { const unsigned wa = (i < 4) ? ga[m][bj].x : ga[m][bj].y, wb = (i < 4) ? gb[m][bj].x : gb[m][bj].y;
                            unsigned qa = (wa >> (8 * (i & 3))) & 255u, qb = (wb >> (8 * (i & 3))) & 255u; qa = qa < 1u ? 1u : qa; qb = qb < 1u ? 1u : qb;
                            f[i] = (b < 3) ? (float)qa * __builtin_amdgcn_rcpf((float)qb) : (float)qa * (1.0f / 255.0f); }
#pragma unroll
                        for (int n = 0; n < 2; ++n)
#pragma unroll
                            for (int j = 0; j < 4; ++j) acc[ai][bj][m][n][j] *= f[4 * n + j];
                        if (b == 3) { v4u o; o.x = cvt_pk_bf16(acc[ai][bj][m][0][0], acc[ai][bj][m][0][1]); o.y = cvt_pk_bf16(acc[ai][bj][m][0][2], acc[ai][bj][m][0][3]); o.z = cvt_pk_bf16(acc[ai][bj][m][1][0], acc[ai][bj][m][1][1]); o.w = cvt_pk_bf16(acc[ai][bj][m][1][2], acc[ai][bj][m][1][3]);
                            *(v4u*)(P.T + (size_t)(row0 + ai * 128 + m * 16) * 2048 + col0 + bj * 128) = o;
                            acc[ai][bj][m][0] = (ACC){0, 0, 0, 0}; acc[ai][bj][m][1] = (ACC){0, 0, 0, 0}; }
                    }
                __builtin_amdgcn_sched_barrier(0);
            }
        }
        if (!has_next) break;
        cur = nxt; cA = nA; cB = nB; ++ui;
        if (wr == 1) PG8_BAR;
    }
    PG8_WAIT_V(0);
    if constexpr (!ALIGN_EPI) { if (wr == 0) PG8_BAR; }
    PG8_BAR;
#undef PG8_SA
#undef PG8_SB
#undef PG8_STAGE
#undef PG8_LDA
#undef PG8_LDB
#undef PG8_MMA
#undef PG8_WAIT_V
#undef PG8_WAIT_L
#undef PG8_BAR
#undef PG8_SCHED
}
}

constexpr int DM = 2048, NB = 8, SEQ = 4096, DEPTH = 4, CTXL = 256;
constexpr int MLAT = NB * SEQ, MCTX = NB * CTXL, MROWS = MLAT + MCTX;
constexpr int ZW = 5888, NGATE = 8192, N1 = ZW + NGATE;
constexpr int Z_AU = 0, Z_AV = 512, Z_AZ = 1024, Z_BQ = 1536, Z_BK = 2048, Z_BV = 2176, Z_BZ = 2304, Z_FIN = 2816, Z_FZ = 3328, Z_DQ = 3840, Z_DK = 4352, Z_DV = 4864, Z_DZ = 5376;
constexpr float EPSN = 1e-6f, LOG2E = 1.4426950408889634f;
constexpr float QSCALE_B = 0.125f * LOG2E, QSCALE_D = 0.17677669529663687f * LOG2E;
constexpr int NWAVES = 8, NTHR = 512;
#ifndef I8_LAYERS
#define I8_LAYERS 8
#endif
__host__ __device__ constexpr bool i8_layer(int l) { return ((I8_LAYERS >> l) & 1) != 0; }

constexpr size_t MiB = 1u << 20;
constexpr size_t WS_CTL = 0, CTL_ZERO_BYTES = 1 * MiB;
constexpr size_t WS_MOD = 1 * MiB;
constexpr size_t WS_ROPE = 2 * MiB;
constexpr size_t WS_MT = 3 * MiB;
constexpr size_t WS_DFTC = 4 * MiB;
constexpr size_t WS_WSB = 4 * MiB + 256 * 1024;
constexpr size_t WS_RSTDA = 5 * MiB;
constexpr size_t WS_HC = 8 * MiB;
constexpr size_t WS_WCAT = 24 * MiB;
constexpr size_t WS_WBR = 79 * MiB;
constexpr size_t WS_WOUT = 87 * MiB;
constexpr size_t WS_COS2 = 96 * MiB;
constexpr size_t WS_SIN2 = 104 * MiB;
constexpr size_t WS_NBUF = 160 * MiB;
constexpr size_t WS_Z = 296 * MiB;
constexpr size_t WS_G = 687 * MiB;
constexpr size_t WS_N8 = 959 * MiB;
constexpr size_t WS_END = 1023 * MiB;
static_assert(I8_LAYERS == 0 || I8_LAYERS == 8, "n8 holds latent rows only: int8 gates are wired for the last layer");
constexpr size_t WS_WG8 = 47 * MiB;
constexpr size_t WS_ROWS = 6 * MiB + 256 * 1024;
constexpr int CW_CMAX = 65536;
constexpr size_t UT_CTX_OFF = 64 * MiB;
constexpr size_t FST_OFF = 16 * MiB;
constexpr size_t WS_UCH = 5 * MiB + 512 * 1024;
constexpr int CW_BAR = 4096;
constexpr int CW_CVQ = 16384;

constexpr int LDS_BYTES = 147456;
constexpr int MISC_OFF = LDS_BYTES - 128;

__device__ __forceinline__ unsigned f2bf(float f) { unsigned u = __builtin_bit_cast(unsigned, f); return (u + 0x7fffu + ((u >> 16) & 1u)) >> 16; }
__device__ __forceinline__ unsigned pk2(float lo, float hi) { return f2bf(lo) | (f2bf(hi) << 16); }
__device__ __forceinline__ float bflo(unsigned w) { return __builtin_bit_cast(float, w << 16); }
__device__ __forceinline__ float bfhi(unsigned w) { return __builtin_bit_cast(float, w & 0xffff0000u); }
__device__ __forceinline__ float bf2f(bf16 h) { return __builtin_bit_cast(float, ((unsigned)h) << 16); }
__device__ __forceinline__ void unpack8(const v4u w, float (&f)[8]) { f[0] = bflo(w.x); f[1] = bfhi(w.x); f[2] = bflo(w.y); f[3] = bfhi(w.y); f[4] = bflo(w.z); f[5] = bfhi(w.z); f[6] = bflo(w.w); f[7] = bfhi(w.w); }
__device__ __forceinline__ v4u pack8(const float (&f)[8]) { v4u w; w.x = pg8::cvt_pk_bf16(f[0], f[1]); w.y = pg8::cvt_pk_bf16(f[2], f[3]); w.z = pg8::cvt_pk_bf16(f[4], f[5]); w.w = pg8::cvt_pk_bf16(f[6], f[7]); return w; }
__device__ __forceinline__ float fast_exp2(float x) { return __builtin_amdgcn_exp2f(x); }
__device__ __forceinline__ float fast_rcp(float x) { return __builtin_amdgcn_rcpf(x); }
__device__ __forceinline__ float sigmoidf_(float x) { return fast_rcp(1.0f + fast_exp2(-LOG2E * x)); }
__device__ __forceinline__ float siluf_(float x) { return x * sigmoidf_(x); }
__device__ __forceinline__ float gelu_tanh(float x) { const float u = 0.7978845608028654f * (x + 0.044715f * x * x * x); return x * fast_rcp(1.0f + fast_exp2(-2.0f * LOG2E * u)); }

#define XB_TMO      128
#define XB_XCNT(j)  (256  + 64 * (j))
#define XB_XSUB(j)  (1280 + 64 * (j))
#define XB_XGEN(j)  (2304 + 64 * (j))
#define XB_TOP      3328
#define XB_TOPGEN   3392
#define XCD_BAR_WORDS 3456
#define XB_SPIN_CAP (1u << 18)
__device__ __forceinline__ unsigned xb_ld(unsigned* p)              { return __hip_atomic_load(p, __ATOMIC_RELAXED, __HIP_MEMORY_SCOPE_AGENT); }
__device__ __forceinline__ unsigned xb_add(unsigned* p, unsigned v) { return __hip_atomic_fetch_add(p, v, __ATOMIC_RELAXED, __HIP_MEMORY_SCOPE_AGENT); }
__device__ __forceinline__ unsigned xb_xcc_id() { return (unsigned)__builtin_amdgcn_s_getreg((3 << 11) | 20) & 0xFu; }
#define XB_SPIN(cond, bar) do { unsigned _sp = 0; while (cond) { __builtin_amdgcn_s_sleep(1); \
    if ((++_sp & 255u) == 0u) { if (xb_ld(&(bar)[XB_TMO])) break; if (_sp > XB_SPIN_CAP) { atomicAdd(&(bar)[XB_TMO], 1u); break; } } } } while (0)
struct XcdBarrier { unsigned* bar; unsigned x; volatile LAS unsigned* st; };
__device__ __forceinline__ XcdBarrier xcd_barrier_post(unsigned* bar, volatile LAS unsigned* st) {
    XcdBarrier b; b.bar = bar; b.x = xb_xcc_id(); b.st = st;
    if (threadIdx.x == 0) (void)xb_add(&bar[XB_XCNT(b.x)], 1u);
    return b;
}
__device__ __forceinline__ void xcd_barrier_complete(unsigned* bar, unsigned x, unsigned& nloc, unsigned& nx) {
    const unsigned G = gridDim.x * gridDim.y * gridDim.z;
    unsigned sum, cnt, mine, sp = 0u;
    for (;;) {
        sum = 0u; cnt = 0u; mine = 0u;
#pragma unroll
        for (unsigned j = 0; j < 16; ++j) { const unsigned c = xb_ld(&bar[XB_XCNT(j)]); sum += c; cnt += (c > 0u) ? 1u : 0u; mine = (j == x) ? c : mine; }
        if (sum == G) break;
        __builtin_amdgcn_s_sleep(1);
        if ((++sp & 255u) == 0u) { if (xb_ld(&bar[XB_TMO])) break; if (sp > XB_SPIN_CAP) { atomicAdd(&bar[XB_TMO], 1u); break; } }
    }
    nloc = mine > 0u ? mine : 1u; nx = cnt > 0u ? cnt : 1u;
}
__device__ __forceinline__ void xcd_barrier(const XcdBarrier& b) {
    asm volatile("s_waitcnt vmcnt(0)" ::: "memory");
    __syncthreads();
    if (threadIdx.x == 0) {
        unsigned* bar = b.bar;
        __builtin_amdgcn_s_waitcnt(0);
        unsigned nloc = b.st[0], nx = b.st[1];
        if (nloc == 0u) { xcd_barrier_complete(bar, b.x, nloc, nx); b.st[0] = nloc; b.st[1] = nx; }
        const unsigned old = xb_add(&bar[XB_XSUB(b.x)], 1u);
        const unsigned gen = old / nloc;
        if (old + 1u == (gen + 1u) * nloc) {
            __builtin_amdgcn_fence(__ATOMIC_RELEASE, "agent");
            asm volatile("s_waitcnt vmcnt(0)" ::: "memory");
            const unsigned og = xb_add(&bar[XB_TOP], 1u);
            const unsigned tg = og / nx;
            if (og + 1u == (tg + 1u) * nx) xb_add(&bar[XB_TOPGEN], 1u);
            else XB_SPIN(xb_ld(&bar[XB_TOPGEN]) == tg, bar);
            __builtin_amdgcn_fence(__ATOMIC_ACQUIRE, "agent");
            xb_add(&bar[XB_XGEN(b.x)], 1u);
            asm volatile("s_waitcnt vmcnt(0)" ::: "memory");
        } else {
            XB_SPIN(xb_ld(&bar[XB_XGEN(b.x)]) == gen, bar);
            __builtin_amdgcn_fence(__ATOMIC_ACQUIRE, "agent");
            asm volatile("s_waitcnt vmcnt(0)" ::: "memory");
        }
    }
    __syncthreads();
}

__device__ __forceinline__ float wave_sum(float v) {
#pragma unroll
    for (int o = 1; o < 64; o <<= 1) v += __shfl_xor(v, o);
    return v;
}

struct PlainProb {
    const char* A; const char* B; unsigned lda, ldb; int K;
    __device__ __forceinline__ const char* a_ptr(const pg8::Unit& u) const { return A + (size_t)u.pm * 256 * lda; }
    __device__ __forceinline__ const char* b_ptr(const pg8::Unit& u) const { return B + (size_t)u.pn * 256 * ldb; }
};
struct DftProb {
    const char* A; const char* B; unsigned lda, ldb; int K;
    __device__ __forceinline__ const char* a_ptr(const pg8::Unit& u) const { return A + (size_t)(u.pm & 15) * 256 * lda; }
    __device__ __forceinline__ const char* b_ptr(const pg8::Unit& u) const { return B + ((size_t)(u.pm >> 4) * 512 + (size_t)u.pn * 256) * ldb; }
};
struct DftCtxProb {
    const char* A; const char* B; unsigned lda, ldb; int K;
    __device__ __forceinline__ const char* a_ptr(const pg8::Unit&) const { return A; }
    __device__ __forceinline__ const char* b_ptr(const pg8::Unit& u) const { return B + ((size_t)u.pm * 512 + (size_t)u.pn * 256) * ldb; }
};

struct P2Order { pg8::StaticOrder full, lat; bool last; int G, c, nlat, maxi;
    __device__ __forceinline__ void init(int G_, int c_, bool last_, int nN) { full.init(MROWS / 256, nN, G_, c_); lat.init(MLAT / 256, nN, G_, c_); last = last_; G = G_; c = c_; nlat = (MLAT / 256) * nN; maxi = 1 << 30; }
    __device__ __forceinline__ bool next(int i, pg8::Unit& u) const {
        if (i >= maxi) return false;
        if (!last) return full.next(i, u);
        if (lat.next(i, u)) return true;
        const int idx = i * G + c - nlat; if (idx >= 40) return false;
        const int t = idx % 5; u.pm = 128 + idx / 5; u.pn = (t == 0) ? 8 : (16 + t); return true; } };

struct CtxDftOrder { int G, c;
    __device__ __forceinline__ bool next(int i, pg8::Unit& u) const {
        if (i != 0) return false;
        int idx;
        if (G >= 160) { if (c >= 136 && c < 144) idx = c - 136; else if (c >= 152 && c < 160) idx = 8 + c - 152; else return false; }
        else { if (c >= 16) return false; idx = c; }
        u.pm = idx >> 1; u.pn = idx & 1; return true; } };

typedef const f32x4 (&AccRef)[2][2][4][2];

struct EpiP2 {
    static constexpr bool PERM = true;
    bf16* Z; unsigned char* G; const float* bqg; const float* bkg; const float* dqg; const float* dkg; const f32x2* rope;
    __device__ __forceinline__ void operator()(AccRef acc, const pg8::Unit& u, int wr, int wc, int fr, int fq) const { run<2>(acc, u.pm * 256, u.pn, wr, wc, fr, fq); }
    template <int NAI>
    __device__ __forceinline__ void run(const f32x4 (&acc)[NAI][2][4][2], int rowbase, int pn, int wr, int wc, int fr, int fq) const {
        const bool isctx = rowbase >= MLAT;
        const int row0 = rowbase + wr * 64 + fr;
        if (pn >= 23) {
            unsigned char* gb = G + (size_t)(pn - 23) * 256 + wc * 32 + 8 * fq;
#pragma unroll
            for (int ai = 0; ai < NAI; ++ai)
#pragma unroll
                for (int m = 0; m < 4; ++m) { const int row = row0 + ai * 128 + m * 16;
#pragma unroll
                    for (int bj = 0; bj < 2; ++bj) { unsigned w0 = 0u, w1 = 0u;
#pragma unroll
                        for (int j = 0; j < 4; ++j) { const unsigned q0 = (unsigned)(sigmoidf_(acc[ai][bj][m][0][j]) * 255.0f + 0.5f), q1 = (unsigned)(sigmoidf_(acc[ai][bj][m][1][j]) * 255.0f + 0.5f);
                            w0 |= q0 << (8 * j); w1 |= q1 << (8 * j); }
                        v2u w; w.x = w0; w.y = w1; *(v2u*)(gb + (size_t)row * NGATE + bj * 128) = w; } }
        } else if (pn >= 6 && pn <= 8) {
            const bool isq = pn < 8, isv = (pn == 8) && (wc >= 2);
            const int colbase = isq ? (Z_BQ + 64 * (4 * (pn - 6) + wc)) : (isv ? (Z_BV + 64 * (wc - 2)) : (Z_BK + 64 * wc));
            const float* gp = isq ? bqg : bkg;
            float gn[2][8];
#pragma unroll
            for (int bj = 0; bj < 2; ++bj)
#pragma unroll
                for (int i = 0; i < 8; ++i) gn[bj][i] = gp[32 * bj + 8 * fq + i];
            const float osc = isq ? QSCALE_B : 1.0f;
            const bool dorope = !isv && !isctx;
            const f32x2* rbase = rope + 8 * (fq & 1);
#pragma unroll
            for (int ai = 0; ai < NAI; ++ai) {
                f32x2 r0[8];
                if (dorope) {
#pragma unroll
                    for (int i = 0; i < 8; ++i) r0[i] = rbase[(((rowbase >> 6) + wr + 2 * ai) & 63) * 16 + i]; }
#pragma unroll
                for (int m = 0; m < 4; ++m) { const int row = row0 + ai * 128 + m * 16;
                    f32x2 r1[8];
                    if (dorope) {
#pragma unroll
                        for (int i = 0; i < 8; ++i) r1[i] = rbase[((fr + 16 * m) & 63) * 16 + i]; }
                    __builtin_amdgcn_sched_barrier(0);
                    float v[2][8];
#pragma unroll
                    for (int bj = 0; bj < 2; ++bj)
#pragma unroll
                        for (int i = 0; i < 8; ++i) v[bj][i] = acc[ai][bj][m][i >> 2][i & 3];
                    if (!isv) {
                        float ss = 0.f;
#pragma unroll
                        for (int bj = 0; bj < 2; ++bj)
#pragma unroll
                            for (int i = 0; i < 8; ++i) ss += v[bj][i] * v[bj][i];
                        ss += __shfl_xor(ss, 16); ss += __shfl_xor(ss, 32);
                        const float rstd = rsqrtf(ss * (1.0f / 64.0f) + EPSN);
#pragma unroll
                        for (int bj = 0; bj < 2; ++bj)
#pragma unroll
                            for (int i = 0; i < 8; ++i) v[bj][i] = v[bj][i] * rstd * gn[bj][i];
                        if (!isctx) {
#pragma unroll
                            for (int bj = 0; bj < 2; ++bj) {
#pragma unroll
                                for (int i = 0; i < 8; ++i) { const f32x2 cs = bj ? r1[i] : r0[i]; const float partner = __shfl_xor(v[bj][i], 32);
                                    v[bj][i] = (fq & 2) ? (v[bj][i] * cs.x + partner * cs.y) : (v[bj][i] * cs.x - partner * cs.y); } }
                        }
#pragma unroll
                        for (int bj = 0; bj < 2; ++bj)
#pragma unroll
                            for (int i = 0; i < 8; ++i) v[bj][i] *= osc;
                    }
#pragma unroll
                    for (int bj = 0; bj < 2; ++bj) *(v4u*)(Z + (size_t)row * ZW + colbase + 32 * bj + 8 * fq) = pack8(v[bj]);
                }
            }
        } else if (pn >= 15 && pn <= 18) {
            const bool isq = pn < 17; const float* gp = isq ? dqg : dkg; const float osc = isq ? QSCALE_D : 1.0f;
            float gn[8];
#pragma unroll
            for (int i = 0; i < 8; ++i) gn[i] = gp[8 * fq + i];
#pragma unroll
            for (int ai = 0; ai < NAI; ++ai)
#pragma unroll
                for (int m = 0; m < 4; ++m) { const int row = row0 + ai * 128 + m * 16;
#pragma unroll
                    for (int bj = 0; bj < 2; ++bj) { float v[8]; float ss = 0.f;
#pragma unroll
                        for (int i = 0; i < 8; ++i) { v[i] = acc[ai][bj][m][i >> 2][i & 3]; ss += v[i] * v[i]; }
                        ss += __shfl_xor(ss, 16); ss += __shfl_xor(ss, 32);
                        const float rstd = rsqrtf(ss * (1.0f / 32.0f) + EPSN) * osc;
#pragma unroll
                        for (int i = 0; i < 8; ++i) v[i] = v[i] * rstd * gn[i];
                        *(v4u*)(Z + (size_t)row * ZW + pn * 256 + bj * 128 + wc * 32 + 8 * fq) = pack8(v); } }
        } else {
            const int act = (pn < 4) ? 1 : ((pn == 11 || pn == 12 || pn == 19 || pn == 20) ? 0 : 2);
#pragma unroll
            for (int ai = 0; ai < NAI; ++ai)
#pragma unroll
                for (int m = 0; m < 4; ++m) { const int row = row0 + ai * 128 + m * 16;
#pragma unroll
                    for (int bj = 0; bj < 2; ++bj) { float v[8];
#pragma unroll
                        for (int i = 0; i < 8; ++i) { const float x = acc[ai][bj][m][i >> 2][i & 3]; v[i] = (act == 1) ? gelu_tanh(x) : ((act == 2) ? siluf_(x) : x); }
                        *(v4u*)(Z + (size_t)row * ZW + pn * 256 + bj * 128 + wc * 32 + 8 * fq) = pack8(v); } }
        }
    }
};

struct EpiC2 {
    static constexpr bool PERM = true;
    bf16* Z; int rowbase; float scale;
    __device__ __forceinline__ void operator()(AccRef acc, const pg8::Unit& u, int wr, int wc, int fr, int fq) const {
        const int row0 = rowbase + u.pm * 256 + wr * 64 + fr;
#pragma unroll
        for (int ai = 0; ai < 2; ++ai) {
            v4u gz[4][2];
#pragma unroll
            for (int m = 0; m < 4; ++m)
#pragma unroll
                for (int bj = 0; bj < 2; ++bj) gz[m][bj] = *(const v4u*)(Z + (size_t)(row0 + ai * 128 + m * 16) * ZW + Z_FZ + u.pn * 256 + bj * 128 + wc * 32 + 8 * fq);
            __builtin_amdgcn_sched_barrier(0);
#pragma unroll
            for (int m = 0; m < 4; ++m) { const int row = row0 + ai * 128 + m * 16;
#pragma unroll
                for (int bj = 0; bj < 2; ++bj) { const int d = u.pn * 256 + bj * 128 + wc * 32 + 8 * fq;
                    float g[8], v[8]; unpack8(gz[m][bj], g);
#pragma unroll
                    for (int i = 0; i < 8; ++i) v[i] = acc[ai][bj][m][i >> 2][i & 3] * scale * g[i];
                    *(v4u*)(Z + (size_t)row * ZW + Z_FIN + d) = pack8(v); } }
            __builtin_amdgcn_sched_barrier(0);
        }
    }
};

struct EpiM1 {
    static constexpr bool PERM = true;
    bf16* T; const unsigned char* G; int b;
    __device__ __forceinline__ void operator()(AccRef acc, const pg8::Unit& u, int wr, int wc, int fr, int fq) const {
        const int row0 = u.pm * 256 + wr * 64 + fr;
#pragma unroll
        for (int ai = 0; ai < 2; ++ai)
#pragma unroll
            for (int m = 0; m < 4; ++m) { const int row = row0 + ai * 128 + m * 16;
#pragma unroll
                for (int bj = 0; bj < 2; ++bj) { const int col = u.pn * 256 + bj * 128 + wc * 32 + 8 * fq;
                    const v2u gq = *(const v2u*)(G + (size_t)row * NGATE + b * 2048 + col);
                    float v[8];
#pragma unroll
                    for (int i = 0; i < 8; ++i) { const unsigned w = (i < 4) ? gq.x : gq.y; const float g = (float)((w >> (8 * (i & 3))) & 255u) * (1.0f / 255.0f); v[i] = acc[ai][bj][m][i >> 2][i & 3] * g; }
                    bf16* tp = T + (size_t)row * DM + col;
                    if (b > 0) { float o[8]; unpack8(*(const v4u*)tp, o);
#pragma unroll
                        for (int i = 0; i < 8; ++i) v[i] += o[i]; }
                    *(v4u*)tp = pack8(v); } }
    }
};

struct EpiM2 {
    static constexpr bool PERM = false;
    const float* hin_lat; float* hout_lat; const float* hin_ctx; float* hout_ctx; const float* mod; const unsigned* flag;
    __device__ __forceinline__ void operator()(AccRef acc, const pg8::Unit& u, int wr, int wc, int fr, int fq) const {
        const int row0 = u.pm * 256 + wr * 64 + fr; const bool isctx = u.pm >= 128;
        const int bi = isctx ? 8 : (row0 >> 12);
        const float* hi0 = isctx ? hin_ctx + (size_t)(row0 - MLAT) * DM : hin_lat + (size_t)row0 * DM;
        float* ho0 = isctx ? hout_ctx + (size_t)(row0 - MLAT) * DM : hout_lat + (size_t)row0 * DM;
        const int colb = u.pn * 256 + wc * 32 + 4 * fq;
        const float* gt = mod + bi * 6144 + 4096 + colb;
        f32x4 g[2][2];
#pragma unroll
        for (int bj = 0; bj < 2; ++bj)
#pragma unroll
            for (int n = 0; n < 2; ++n) g[bj][n] = *(const f32x4*)(gt + bj * 128 + 16 * n);
#pragma unroll
        for (int ai = 0; ai < 2; ++ai) {
            f32x4 h[4][2][2];
#pragma unroll
            for (int m = 0; m < 4; ++m)
#pragma unroll
                for (int bj = 0; bj < 2; ++bj)
#pragma unroll
                    for (int n = 0; n < 2; ++n) h[m][bj][n] = *(const f32x4*)(hi0 + (size_t)(ai * 128 + m * 16) * DM + colb + bj * 128 + 16 * n);
            __builtin_amdgcn_sched_barrier(0);
#pragma unroll
            for (int m = 0; m < 4; ++m)
#pragma unroll
                for (int bj = 0; bj < 2; ++bj)
#pragma unroll
                    for (int n = 0; n < 2; ++n) *(f32x4*)(ho0 + (size_t)(ai * 128 + m * 16) * DM + colb + bj * 128 + 16 * n) = h[m][bj][n] + g[bj][n] * acc[ai][bj][m][n];
            __builtin_amdgcn_sched_barrier(0);
        }
        if (flag && u.pm == 0 && u.pn == 0 && wr == 0 && wc == 0 && fr == 0 && fq == 0 && *flag != 0u) { asm volatile("s_waitcnt vmcnt(0)" ::: "memory"); hout_lat[0] = __builtin_nanf(""); }
    }
};

struct QuarterOrder { int G, c;
    __device__ __forceinline__ bool next(int i, pg8::Unit& u) const { const int q = i * G + c; if (q >= 256) return false; u.pm = q >> 2; u.pn = q & 3; return true; } };
struct M2CtxProb {
    const char* A; const char* B; unsigned lda, ldb; int K;
    __device__ __forceinline__ const char* a_ptr(const pg8::Unit& u) const { return A + (size_t)(128 + (u.pm >> 3)) * 256 * lda + (size_t)u.pn * 512 * 2; }
    __device__ __forceinline__ const char* b_ptr(const pg8::Unit& u) const { return B + (size_t)(u.pm & 7) * 256 * ldb + (size_t)u.pn * 512 * 2; }
};
struct EpiM2Ctx {
    static constexpr bool PERM = false;
    float* hc; const float* mod;
    __device__ __forceinline__ void operator()(AccRef acc, const pg8::Unit& u, int wr, int wc, int fr, int fq) const {
        const int row0 = (u.pm >> 3) * 256 + wr * 64 + fr, colb = (u.pm & 7) * 256 + wc * 32 + 4 * fq;
        const float* gt = mod + 8 * 6144 + 4096;
#pragma unroll
        for (int ai = 0; ai < 2; ++ai)
#pragma unroll
            for (int m = 0; m < 4; ++m) { float* ho = hc + (size_t)(row0 + ai * 128 + m * 16) * DM;
#pragma unroll
                for (int bj = 0; bj < 2; ++bj)
#pragma unroll
                    for (int n = 0; n < 2; ++n) { const int col = colb + bj * 128 + 16 * n; const f32x4 g = *(const f32x4*)(gt + col);
#pragma unroll
                        for (int j = 0; j < 4; ++j) unsafeAtomicAdd(ho + col + j, g[j] * acc[ai][bj][m][n][j]); } }
    }
};

struct EpiNull {
    static constexpr bool PERM = true;
    __device__ __forceinline__ void operator()(AccRef acc, const pg8::Unit& u, int wr, int wc, int fr, int fq) const {
#pragma unroll
        for (int ai = 0; ai < 2; ++ai)
#pragma unroll
            for (int bj = 0; bj < 2; ++bj)
#pragma unroll
                for (int m = 0; m < 4; ++m)
#pragma unroll
                    for (int n = 0; n < 2; ++n) asm volatile("" :: "v"(acc[ai][bj][m][n][0]), "v"(acc[ai][bj][m][n][1]), "v"(acc[ai][bj][m][n][2]), "v"(acc[ai][bj][m][n][3]));
    }
};

struct EpiGate {
    static constexpr bool PERM = true;
    unsigned char* G; const float* rows; const unsigned* cmax;
    __device__ __forceinline__ void operator()(const pg8::i32x4 (&acc)[2][2][4][2], const pg8::Unit& u, int wr, int wc, int fr, int fq) const {
        const int row0 = u.pm * 256 + wr * 64 + fr, col0 = u.pn * 256 + wc * 32 + 8 * fq;
        float cs[2][8];
#pragma unroll
        for (int bj = 0; bj < 2; ++bj) { const v4u a = *(const v4u*)(cmax + col0 + bj * 128), b = *(const v4u*)(cmax + col0 + bj * 128 + 4);
            cs[bj][0] = __builtin_bit_cast(float, a.x); cs[bj][1] = __builtin_bit_cast(float, a.y); cs[bj][2] = __builtin_bit_cast(float, a.z); cs[bj][3] = __builtin_bit_cast(float, a.w);
            cs[bj][4] = __builtin_bit_cast(float, b.x); cs[bj][5] = __builtin_bit_cast(float, b.y); cs[bj][6] = __builtin_bit_cast(float, b.z); cs[bj][7] = __builtin_bit_cast(float, b.w); }
        float rsv[2][4];
#pragma unroll
        for (int ai = 0; ai < 2; ++ai)
#pragma unroll
            for (int m = 0; m < 4; ++m) rsv[ai][m] = rows[row0 + ai * 128 + m * 16];
        __builtin_amdgcn_sched_barrier(0);
#pragma unroll
        for (int ai = 0; ai < 2; ++ai)
#pragma unroll
            for (int m = 0; m < 4; ++m) { const int row = row0 + ai * 128 + m * 16; const float rs = rsv[ai][m] * (-LOG2E / 127.0f);
#pragma unroll
                for (int bj = 0; bj < 2; ++bj) { unsigned w0 = 0u, w1 = 0u;
#pragma unroll
                    for (int j = 0; j < 4; ++j) {
                        const float x0 = (float)acc[ai][bj][m][0][j] * (rs * cs[bj][j]), x1 = (float)acc[ai][bj][m][1][j] * (rs * cs[bj][4 + j]);
                        const unsigned q0 = (unsigned)(fast_rcp(1.0f + fast_exp2(x0)) * 255.0f + 0.5f), q1 = (unsigned)(fast_rcp(1.0f + fast_exp2(x1)) * 255.0f + 0.5f);
                        w0 |= q0 << (8 * j); w1 |= q1 << (8 * j); }
                    v2u w; w.x = w0; w.y = w1; *(v2u*)(G + (size_t)row * NGATE + col0 + bj * 128) = w; } }
    }
};

struct Args { const float* in[21]; float* out; unsigned char* ws; int ph_lo, ph_hi; };
enum { I_X = 0, I_C, I_CTX, I_CCTX, I_NORMG, I_WADA, I_BADA, I_WIN, I_ANG, I_AWS, I_ABS, I_BQG, I_BKG, I_BSINK, I_CWF, I_DQG, I_DKG, I_RPB, I_WGATE, I_WBR, I_WOUT };

struct Frame {
    LAS unsigned char* lds; int tid, lane, wave, G, gw, NGW, gtid, NT;
};
__device__ __forceinline__ Frame make_frame(LAS unsigned char* lds) {
    Frame F; int t = threadIdx.x; asm volatile("" : "+v"(t));
    F.lds = lds; F.tid = t; F.lane = t & 63; F.wave = __builtin_amdgcn_readfirstlane(t >> 6);
    F.G = gridDim.x; F.gw = blockIdx.x * NWAVES + F.wave; F.NGW = F.G * NWAVES; F.gtid = blockIdx.x * NTHR + t; F.NT = F.G * NTHR;
    return F;
}

__device__ __forceinline__ void build_costab(Frame& F) {
    LAS float* T = (LAS float*)F.lds;
    for (int t = F.tid; t < 4096; t += NTHR) T[t] = cospif((float)t * (1.0f / 2048.0f));
    __syncthreads();
}
__device__ __forceinline__ void pro_mod(Frame& F, const float* c, const float* cctx, const float* wada, const float* bada, const float* normg, float* mod) {
    LAS float* sc = (LAS float*)(F.lds + 16384);
    LAS float* red = (LAS float*)(F.lds + 16384 + 73728);
    for (int i = F.tid; i < 9 * 2048; i += NTHR) { const float x = (i < 8 * 2048) ? c[i] : cctx[i - 8 * 2048]; sc[i] = x / (1.0f + expf(-x)); }
    __syncthreads();
    const int kg = F.tid >> 7, cl = F.tid & 127;
    for (int item = blockIdx.x; item < DEPTH * 48; item += F.G) {
        const int l = item / 48, j = (item % 48) * 128 + cl;
        const float* wp = wada + (size_t)l * 2048 * 6144 + (size_t)(kg * 512) * 6144 + j;
        float a[9];
#pragma unroll
        for (int b = 0; b < 9; ++b) a[b] = 0.f;
#pragma unroll 1
        for (int k0 = 0; k0 < 512; k0 += 16) {
            float w[16];
#pragma unroll
            for (int i = 0; i < 16; ++i) w[i] = wp[(size_t)(k0 + i) * 6144];
            __builtin_amdgcn_sched_barrier(0);
#pragma unroll
            for (int i = 0; i < 16; ++i)
#pragma unroll
                for (int b = 0; b < 9; ++b) a[b] += sc[b * 2048 + kg * 512 + k0 + i] * w[i]; }
#pragma unroll
        for (int b = 0; b < 9; ++b) red[(kg * 9 + b) * 128 + cl] = a[b];
        __syncthreads();
        for (int i = F.tid; i < 9 * 128; i += NTHR) { const int b = i >> 7, cc = i & 127; const int jj = (item % 48) * 128 + cc;
            float mv = ((red[(0 * 9 + b) * 128 + cc] + red[(1 * 9 + b) * 128 + cc]) + (red[(2 * 9 + b) * 128 + cc] + red[(3 * 9 + b) * 128 + cc])) + bada[l * 6144 + jj];
            if (jj >= 2048 && jj < 4096) mv = (1.0f + mv) * normg[l * DM + jj - 2048];
            mod[((size_t)l * 9 + b) * 6144 + jj] = mv; }
        __syncthreads();
    }
}
__device__ __forceinline__ void pro_colmax(Frame& F, const float* wgate, unsigned* cmax) {
    for (int item = blockIdx.x; item < DEPTH * 4 * 16 * 4; item += F.G) {
        const int cg = item & 3, kc = (item >> 2) & 15, lb = item >> 6;
        if (!i8_layer(lb >> 2)) continue;
        const float* wp = wgate + ((size_t)lb * DM + kc * 128) * DM + cg * 512 + F.tid; float mx = 0.f;
#pragma unroll 1
        for (int k0 = 0; k0 < 128; k0 += 16) { float w[16];
#pragma unroll
            for (int i = 0; i < 16; ++i) w[i] = wp[(size_t)(k0 + i) * DM];
            __builtin_amdgcn_sched_barrier(0);
#pragma unroll
            for (int i = 0; i < 16; ++i) mx = fmaxf(mx, fabsf(w[i])); }
        atomicMax(cmax + (size_t)lb * DM + cg * 512 + F.tid, __builtin_bit_cast(unsigned, mx));
    }
}
__device__ __forceinline__ void pro_tables(Frame& F, const float* cwf, bf16* cos2, bf16* sin2, bf16* dftc, f32x2* rope, bf16* mt, const float* aws, bf16* wsb) {
    const LAS float* T = (const LAS float*)F.lds;
    for (int it = F.gtid; it < DEPTH * 4 * 128 * 128; it += F.NT) wsb[it] = (bf16)f2bf(aws[it]);
    for (int it = F.gtid; it < 2 * 2048 * 256; it += F.NT) { const int part = it >> 19, r = it & ((1 << 19) - 1), k = r >> 8, l0 = (r & 255) * 8;
        float v[8];
#pragma unroll
        for (int i = 0; i < 8; ++i) { const int idx = (k * (l0 + i)) & 4095; v[i] = T[part ? ((idx - 1024) & 4095) : idx]; }
        *(v4u*)((part ? sin2 : cos2) + (size_t)k * 2048 + l0) = pack8(v); }
    for (int it = F.gtid; it < 256 * 64; it += F.NT) { const int k = it >> 6, c0 = (it & 63) * 8; const int part = c0 >> 8, l0 = c0 & 255;
        float v[8];
#pragma unroll
        for (int i = 0; i < 8; ++i) { const int idx = ((k * (l0 + i)) & 255) * 16; v[i] = T[part ? ((idx - 1024) & 4095) : idx]; }
        *(v4u*)(dftc + (size_t)k * 512 + c0) = pack8(v); }
    for (int it = F.gtid; it < 1024; it += F.NT) { const int p = it >> 4, i = it & 15; const float inv = powf(10000.0f, -(float)i * (1.0f / 16.0f)); const float ang = (float)p * inv;
        f32x2 cs; cs.x = cosf(ang); cs.y = sinf(ang); rope[it] = cs; }
    for (int it = F.gtid; it < DEPTH * 4 * 2 * 128 * 128; it += F.NT) { const int c = it & 127, d = (it >> 7) & 127, part = (it >> 14) & 1, lg = it >> 15;
        const float* wf = cwf + (size_t)lg * 128 * 128 + d; float s = 0.f;
        for (int m = 0; m < 128; ++m) { const int idx = ((m * c) & 127) * 32; s += T[part ? ((idx - 1024) & 4095) : idx] * wf[m * 128]; }
        mt[it] = (bf16)f2bf(part ? -s : s); }
}

__device__ __forceinline__ void transpose_item(const float* W, int N, int k0, int n0, bf16* WT, int K, int drow0, LAS float* scr, int lane) {
    float tmp[32];
    const float* wp = W + (size_t)(k0 + (lane >> 5)) * N + n0 + (lane & 31);
#pragma unroll
    for (int i = 0; i < 32; ++i) tmp[i] = wp[(size_t)(2 * i) * N];
#pragma unroll
    for (int i = 0; i < 32; ++i) { const int kk = 2 * i + (lane >> 5); scr[kk * 33 + (lane & 31)] = tmp[i]; }
    asm volatile("s_waitcnt lgkmcnt(0)" ::: "memory");
    const int c = lane & 7;
#pragma unroll
    for (int j = 0; j < 4; ++j) { const int n = (lane >> 3) + 8 * j; const LAS float* s = scr + (8 * c) * 33 + n;
        v4u o; o.x = pk2(s[0 * 33], s[1 * 33]); o.y = pk2(s[2 * 33], s[3 * 33]); o.z = pk2(s[4 * 33], s[5 * 33]); o.w = pk2(s[6 * 33], s[7 * 33]);
        *(v4u*)(WT + (size_t)(drow0 + n) * K + k0 + 8 * c) = o; }
    asm volatile("s_waitcnt lgkmcnt(0)" ::: "memory");
}
__device__ __forceinline__ void quant_item(const float* W, int N, int k0, int n0, signed char* WT, int drow0, const unsigned* cmax, LAS float* scr, int lane) {
    float tmp[32];
    const float* wp = W + (size_t)(k0 + (lane >> 5)) * N + n0 + (lane & 31);
#pragma unroll
    for (int i = 0; i < 32; ++i) tmp[i] = wp[(size_t)(2 * i) * N];
#pragma unroll
    for (int i = 0; i < 32; ++i) { const int kk = 2 * i + (lane >> 5); scr[kk * 33 + (lane & 31)] = tmp[i]; }
    asm volatile("s_waitcnt lgkmcnt(0)" ::: "memory");
    const int n = lane >> 1, kh = lane & 1;
    const float am = __builtin_bit_cast(float, cmax[n0 + n]); const float inv = am > 0.f ? 127.0f / am : 0.f;
    unsigned w[8];
#pragma unroll
    for (int d = 0; d < 8; ++d) { unsigned acc = 0u;
#pragma unroll
        for (int e = 0; e < 4; ++e) { const int q = (int)rintf(scr[(32 * kh + 4 * d + e) * 33 + n] * inv); acc |= ((unsigned)q & 255u) << (8 * e); }
        w[d] = acc; }
    signed char* dst = WT + (size_t)(drow0 + n) * DM + k0 + 32 * kh;
    v4u o0; o0.x = w[0]; o0.y = w[1]; o0.z = w[2]; o0.w = w[3]; v4u o1; o1.x = w[4]; o1.y = w[5]; o1.z = w[6]; o1.w = w[7];
    *(v4u*)dst = o0; *(v4u*)(dst + 16) = o1;
    asm volatile("s_waitcnt lgkmcnt(0)" ::: "memory");
}
__device__ __forceinline__ int win_dest_row(int n0) {
    if (n0 >= Z_BQ && n0 < Z_BK) { const int j = n0 - Z_BQ, H = j >> 6, s = (j >> 5) & 1; return Z_BQ + 256 * (H >> 2) + 128 * s + 32 * (H & 3); }
    if (n0 >= Z_BK && n0 < Z_BV) { const int j = n0 - Z_BK, h = j >> 6, s = (j >> 5) & 1; return Z_BK + 128 * s + 32 * h; }
    if (n0 >= Z_BV && n0 < Z_BZ) { const int j = n0 - Z_BV, h = j >> 6, s = (j >> 5) & 1; return Z_BK + 128 * s + 32 * (h + 2); }
    return n0;
}
constexpr int CV_IN = 32 * (ZW / 32), CV_GT = 4 * 32 * 64, CV_BR = 4 * 8 * 64, CV_OUT = 32 * 64, CV_ALL = CV_IN + CV_GT + CV_BR + CV_OUT;
__device__ __forceinline__ void convert_item(const Args& a, int l, int it, LAS float* scr, int lane) {
    unsigned char* ws = a.ws;
    bf16* wcat = (bf16*)(ws + WS_WCAT); bf16* wbr = (bf16*)(ws + WS_WBR); bf16* wout = (bf16*)(ws + WS_WOUT);
    int r = it;
    if (r < CV_IN) { const float* win = a.in[I_WIN] + (size_t)l * DM * ZW; const int nb = r % (ZW / 32), kb = r / (ZW / 32); transpose_item(win, ZW, kb * 64, nb * 32, wcat, DM, win_dest_row(nb * 32), scr, lane); return; } r -= CV_IN;
    if (r < CV_GT) { const float* wgate = a.in[I_WGATE] + (size_t)l * 4 * DM * DM; const int b = r / 2048, q = r % 2048, nb = q % 64, kb = q / 64;
        if (!i8_layer(l)) { transpose_item(wgate + (size_t)b * DM * DM, DM, kb * 64, nb * 32, wcat, DM, ZW + b * 2048 + nb * 32, scr, lane); return; }
        quant_item(wgate + (size_t)b * DM * DM, DM, kb * 64, nb * 32, (signed char*)(ws + WS_WG8), b * 2048 + nb * 32, (const unsigned*)(ws + WS_CTL) + CW_CMAX + (size_t)l * 8192 + b * 2048, scr, lane); return; } r -= CV_GT;
    if (r < CV_BR) { const float* wbrs = a.in[I_WBR] + (size_t)l * 4 * 512 * DM; const int b = r / 512, q = r % 512, nb = q % 64, kb = q / 64; transpose_item(wbrs + (size_t)b * 512 * DM, DM, kb * 64, nb * 32, wbr + (size_t)b * DM * 512, 512, nb * 32, scr, lane); return; } r -= CV_BR;
    { const float* wouts = a.in[I_WOUT] + (size_t)l * DM * DM; const int nb = r % 64, kb = r / 64; transpose_item(wouts, DM, kb * 64, nb * 32, wout, DM, nb * 32, scr, lane); }
}
__device__ __forceinline__ void phase_convert(LAS unsigned char* lds_, const Args& a, int l, int it_lo, int it_hi, unsigned* ctr, int max_grabs = 1 << 30) {
    Frame F = make_frame(lds_);
    LAS float* scr = (LAS float*)(F.lds + F.wave * 16384);
    if (!ctr) { for (int it = it_lo + F.gw; it < it_hi; it += F.NGW) convert_item(a, l, it, scr, F.lane); }
    else {
        for (int gcount = 0; gcount < max_grabs; ++gcount) {
            unsigned base = 0u; if (F.lane == 0) base = __hip_atomic_fetch_add(ctr, 4u, __ATOMIC_RELAXED, __HIP_MEMORY_SCOPE_AGENT);
            const int i0 = it_lo + (int)__builtin_amdgcn_readfirstlane(base);
            if (i0 >= it_hi) break;
#pragma unroll 1
            for (int k = 0; k < 4; ++k) if (i0 + k < it_hi) convert_item(a, l, i0 + k, scr, F.lane);
        }
    }
}
__device__ __forceinline__ void phase_hc_init(LAS unsigned char* lds_, const Args& a) {
    Frame F = make_frame(lds_);
    for (int i = F.gtid; i < MCTX * DM / 4; i += F.NT) ((f32x4*)(a.ws + WS_HC))[i] = ((const f32x4*)a.in[I_CTX])[i];
}
__device__ __forceinline__ void phase_norm(LAS unsigned char* lds_, const Args& a, int l) {
    Frame F = make_frame(lds_);
    unsigned char* ws = a.ws;
    const float* hl = l ? a.out : a.in[I_X]; const float* hc = l ? (const float*)(ws + WS_HC) : a.in[I_CTX];
    const float* mod = (const float*)(ws + WS_MOD) + (size_t)l * 9 * 6144;
    bf16* nbuf = (bf16*)(ws + WS_NBUF); signed char* n8 = (signed char*)(ws + WS_N8); float* rowsc = (float*)(ws + WS_ROWS);
    f32x4 vn[8];
    { const int row = F.gw; if (row < MROWS) { const float* hr = row >= MLAT ? hc + (size_t)(row - MLAT) * DM : hl + (size_t)row * DM;
#pragma unroll
        for (int j = 0; j < 8; ++j) vn[j] = *(const f32x4*)(hr + j * 256 + F.lane * 4); } }
    for (int row = F.gw; row < MROWS; row += F.NGW) {
        const bool isctx = row >= MLAT; const int bi = isctx ? 8 : (row >> 12);
        const float* sh = mod + bi * 6144; const float* scp = sh + 2048;
        f32x4 v[8]; float ss = 0.f;
#pragma unroll
        for (int j = 0; j < 8; ++j) v[j] = vn[j];
        f32x4 pa[8], ps[8];
#pragma unroll
        for (int j = 0; j < 8; ++j) { const int c = j * 256 + F.lane * 4; pa[j] = *(const f32x4*)(scp + c); ps[j] = *(const f32x4*)(sh + c); }
        __builtin_amdgcn_sched_barrier(0);
        { int nrow = row + F.NGW; nrow = nrow < MROWS ? nrow : row;
            const float* hr = nrow >= MLAT ? hc + (size_t)(nrow - MLAT) * DM : hl + (size_t)nrow * DM;
#pragma unroll
            for (int j = 0; j < 8; ++j) vn[j] = *(const f32x4*)(hr + j * 256 + F.lane * 4); }
        __builtin_amdgcn_sched_barrier(0);
#pragma unroll
        for (int j = 0; j < 8; ++j) ss += (v[j].x * v[j].x + v[j].y * v[j].y) + (v[j].z * v[j].z + v[j].w * v[j].w);
        const float rstd = rsqrtf(wave_sum(ss) * (1.0f / DM) + EPSN);
#pragma unroll
        for (int j = 0; j < 8; ++j) { const int c = j * 256 + F.lane * 4;
            const f32x4 o = v[j] * rstd * pa[j] + ps[j]; v[j] = o;
            v2u w; w.x = pk2(o.x, o.y); w.y = pk2(o.z, o.w); *(v2u*)(nbuf + (size_t)row * DM + c) = w; }
        if (!i8_layer(l) || row >= MLAT) continue;
        float am = 0.f;
#pragma unroll
        for (int j = 0; j < 8; ++j) am = fmaxf(am, fmaxf(fmaxf(fabsf(v[j].x), fabsf(v[j].y)), fmaxf(fabsf(v[j].z), fabsf(v[j].w))));
#pragma unroll
        for (int o_ = 1; o_ < 64; o_ <<= 1) am = fmaxf(am, __shfl_xor(am, o_));
        const float inv = am > 0.f ? 127.0f / am : 0.f;
        if (F.lane == 0) rowsc[row] = am * (1.0f / 127.0f);
#pragma unroll
        for (int j = 0; j < 8; ++j) { const int q0 = (int)rintf(v[j].x * inv), q1 = (int)rintf(v[j].y * inv), q2 = (int)rintf(v[j].z * inv), q3 = (int)rintf(v[j].w * inv);
            *(unsigned*)(n8 + (size_t)row * DM + j * 256 + F.lane * 4) = ((unsigned)q0 & 255u) | (((unsigned)q1 & 255u) << 8) | (((unsigned)q2 & 255u) << 16) | (((unsigned)q3 & 255u) << 24); }
    }
}

__device__ __forceinline__ void phase_x1(LAS unsigned char* lds_, const Args& a, int l, bool last) {
    Frame F = make_frame(lds_);
    unsigned char* ws = a.ws; const bf16* Z = (const bf16*)(ws + WS_Z); float* rstda = (float*)(ws + WS_RSTDA);
    const int nrows = last ? MLAT : MROWS;
#pragma unroll 1
    for (int row0 = F.gw; row0 < nrows; row0 += 6 * F.NGW) {
        v4u t[6];
#pragma unroll
        for (int j = 0; j < 6; ++j) { const int row = row0 + j * F.NGW; t[j] = (v4u){0u, 0u, 0u, 0u}; if (row < nrows) t[j] = *(const v4u*)(Z + (size_t)row * ZW + Z_AV + F.lane * 8); }
        __builtin_amdgcn_sched_barrier(0);
#pragma unroll
        for (int j = 0; j < 6; ++j) { const int row = row0 + j * F.NGW; float f[8]; unpack8(t[j], f); float ss = 0.f;
#pragma unroll
            for (int i = 0; i < 8; ++i) ss += f[i] * f[i];
            ss = wave_sum(ss);
            if (F.lane == 0 && row < nrows) rstda[row] = rsqrtf(ss * (1.0f / 512.0f) + EPSN); }
    }
}

__device__ __forceinline__ void phase_c1_naive(LAS unsigned char* lds_, const Args& a, int l) {
    Frame F = make_frame(lds_);
    unsigned char* ws = a.ws; const bf16* Z = (const bf16*)(ws + WS_Z);
    const bf16* mt = (const bf16*)(ws + WS_MT) + (size_t)l * 4 * 2 * 128 * 128;
    bf16* ut = (bf16*)(ws + WS_NBUF); bf16* utc = (bf16*)(ws + WS_NBUF + UT_CTX_OFF);
    constexpr int NL = NB * 512 * 2 * 64, NC = NB * 512 * 2 * 4;
    for (int it = F.gw; it < NL + NC; it += F.NGW) {
        const bool isctx = it >= NL; const int r = isctx ? it - NL : it;
        const int pg = isctx ? (r & 3) : (r & 63), rest = isctx ? (r >> 2) : (r >> 6), part = rest & 1, d = (rest >> 1) & 511, b = rest >> 10;
        const int pos = pg * 64 + F.lane, g = d >> 7;
        const bf16* xr = Z + (size_t)(isctx ? MLAT + b * CTXL + pos : b * SEQ + pos) * ZW + Z_FIN + g * 128;
        const bf16* mr = mt + ((size_t)(g * 2 + part) * 128 + (d & 127)) * 128;
        float s = 0.f;
#pragma unroll 4
        for (int c8 = 0; c8 < 16; ++c8) { float x[8], w[8]; unpack8(*(const v4u*)(xr + c8 * 8), x); unpack8(*(const v4u*)(mr + c8 * 8), w);
#pragma unroll
            for (int i = 0; i < 8; ++i) s += x[i] * w[i]; }
        if (isctx) utc[((size_t)b * 512 + d) * 512 + part * 256 + pos] = (bf16)f2bf(s);
        else ut[((size_t)b * 512 + d) * 8192 + part * 4096 + pos] = (bf16)f2bf(s);
    }
}

__device__ __forceinline__ void phase_a_naive(LAS unsigned char* lds_, const Args& a, int l) {
    Frame F = make_frame(lds_);
    unsigned char* ws = a.ws; bf16* Z = (bf16*)(ws + WS_Z); const float* rstda = (const float*)(ws + WS_RSTDA);
    const float* wsp = a.in[I_AWS] + (size_t)l * 4 * 128 * 128; const float* bsp = a.in[I_ABS] + l * 4 * 128; const float* gv = a.in[I_ANG] + l * 512;
    for (int it = F.gtid; it < MROWS * 64; it += F.NT) {
        const int cg = it & 63, row = it >> 6, c0 = cg * 8, g = cg >> 4, t = row & 127, chunk0 = row & ~127;
        const float* wr_ = wsp + ((size_t)g * 128 + t) * 128;
        float mix[8];
#pragma unroll
        for (int i = 0; i < 8; ++i) mix[i] = 0.f;
        for (int s = 0; s < 128; ++s) { float x[8]; unpack8(*(const v4u*)(Z + (size_t)(chunk0 + s) * ZW + Z_AV + c0), x); const float w = wr_[s] * rstda[chunk0 + s];
#pragma unroll
            for (int i = 0; i < 8; ++i) mix[i] += w * x[i]; }
        float u[8], zz[8], o[8]; unpack8(*(const v4u*)(Z + (size_t)row * ZW + Z_AU + c0), u); unpack8(*(const v4u*)(Z + (size_t)row * ZW + Z_AZ + c0), zz);
        const float bias = bsp[g * 128 + t];
#pragma unroll
        for (int i = 0; i < 8; ++i) o[i] = u[i] * (mix[i] * gv[c0 + i] + bias) * zz[i];
        *(v4u*)(Z + (size_t)row * ZW + Z_AU + c0) = pack8(o);
    }
}

__device__ __forceinline__ void phase_b_naive(LAS unsigned char* lds_, const Args& a, int l) {
    Frame F = make_frame(lds_);
    unsigned char* ws = a.ws; bf16* Z = (bf16*)(ws + WS_Z); const float* sink = a.in[I_BSINK] + l * 8;
    for (int it = F.gtid; it < MROWS * 8; it += F.NT) {
        const int H = it / MROWS, row = it - H * MROWS, kh = H >> 2; const bool isctx = row >= MLAT;
        const int b = isctx ? ((row - MLAT) >> 8) : (row >> 12), pos = row & 4095;
        const int k0 = isctx ? 0 : (pos > 128 ? pos - 128 : 0), k1 = isctx ? -1 : (pos + 128 < SEQ ? pos + 128 : SEQ - 1), nloc = k1 - k0 + 1;
        float q[64], o[64];
#pragma unroll
        for (int c8 = 0; c8 < 8; ++c8) { float t8[8]; unpack8(*(const v4u*)(Z + (size_t)row * ZW + Z_BQ + H * 64 + c8 * 8), t8);
#pragma unroll
            for (int i = 0; i < 8; ++i) { q[c8 * 8 + i] = t8[i]; o[c8 * 8 + i] = 0.f; } }
        float mx = -1e30f, den = 0.f;
        for (int t = 0; t < nloc + CTXL; ++t) {
            const size_t krow = (t < nloc) ? (size_t)(b * SEQ + k0 + t) : (size_t)(MLAT + b * CTXL + (t - nloc));
            const bf16* kp = Z + krow * ZW + Z_BK + kh * 64; const bf16* vp = Z + krow * ZW + Z_BV + kh * 64;
            float s = 0.f;
#pragma unroll
            for (int c8 = 0; c8 < 8; ++c8) { float t8[8]; unpack8(*(const v4u*)(kp + c8 * 8), t8);
#pragma unroll
                for (int i = 0; i < 8; ++i) s += q[c8 * 8 + i] * t8[i]; }
            const float mn = fmaxf(mx, s), al = fast_exp2(mx - mn), p = fast_exp2(s - mn);
            den = den * al + p; mx = mn;
#pragma unroll
            for (int c8 = 0; c8 < 8; ++c8) { float t8[8]; unpack8(*(const v4u*)(vp + c8 * 8), t8);
#pragma unroll
                for (int i = 0; i < 8; ++i) o[c8 * 8 + i] = o[c8 * 8 + i] * al + p * t8[i]; }
        }
        den += fast_exp2(sink[H] * LOG2E - mx);
        const float inv = 1.0f / den;
#pragma unroll
        for (int c8 = 0; c8 < 8; ++c8) { float zz[8], r8[8]; unpack8(*(const v4u*)(Z + (size_t)row * ZW + Z_BZ + H * 64 + c8 * 8), zz);
#pragma unroll
            for (int i = 0; i < 8; ++i) r8[i] = o[c8 * 8 + i] * inv * zz[i];
            *(v4u*)(Z + (size_t)row * ZW + Z_BQ + H * 64 + c8 * 8) = pack8(r8); }
    }
}

__device__ __forceinline__ void phase_d_naive(LAS unsigned char* lds_, const Args& a, int l) {
    Frame F = make_frame(lds_);
    unsigned char* ws = a.ws; bf16* Z = (bf16*)(ws + WS_Z); const float* rpb = a.in[I_RPB] + (size_t)l * 16 * 15 * 31;
    for (int it = F.gtid; it < MROWS * 16; it += F.NT) {
        const int h = it / MROWS, row = it - h * MROWS; const bool isctx = row >= MLAT;
        const int b = isctx ? ((row - MLAT) >> 8) : (row >> 12), pos = row & 4095, r = pos >> 6, c = pos & 63;
        const int r0 = (r - 4 < 0) ? 0 : ((r - 4 > 56) ? 56 : r - 4), c0 = (c - 8 < 0) ? 0 : ((c - 8 > 48) ? 48 : c - 8);
        const int nloc = isctx ? 0 : 128;
        float q[32], o[32];
#pragma unroll
        for (int c8 = 0; c8 < 4; ++c8) { float t8[8]; unpack8(*(const v4u*)(Z + (size_t)row * ZW + Z_DQ + h * 32 + c8 * 8), t8);
#pragma unroll
            for (int i = 0; i < 8; ++i) { q[c8 * 8 + i] = t8[i]; o[c8 * 8 + i] = 0.f; } }
        float mx = -1e30f, den = 0.f;
        for (int t = 0; t < nloc + CTXL; ++t) {
            size_t krow; float bias = 0.f;
            if (t < nloc) { const int i = t >> 4, j = t & 15; krow = (size_t)(b * SEQ + (r0 + i) * 64 + c0 + j); bias = rpb[(h * 15 + (r0 + i - r + 7)) * 31 + (c0 + j - c + 15)] * LOG2E; }
            else krow = (size_t)(MLAT + b * CTXL + (t - nloc));
            const bf16* kp = Z + krow * ZW + Z_DK + h * 32; const bf16* vp = Z + krow * ZW + Z_DV + h * 32;
            float s = bias;
#pragma unroll
            for (int c8 = 0; c8 < 4; ++c8) { float t8[8]; unpack8(*(const v4u*)(kp + c8 * 8), t8);
#pragma unroll
                for (int i = 0; i < 8; ++i) s += q[c8 * 8 + i] * t8[i]; }
            const float mn = fmaxf(mx, s), al = fast_exp2(mx - mn), p = fast_exp2(s - mn);
            den = den * al + p; mx = mn;
#pragma unroll
            for (int c8 = 0; c8 < 4; ++c8) { float t8[8]; unpack8(*(const v4u*)(vp + c8 * 8), t8);
#pragma unroll
                for (int i = 0; i < 8; ++i) o[c8 * 8 + i] = o[c8 * 8 + i] * al + p * t8[i]; }
        }
        const float inv = 1.0f / den;
#pragma unroll
        for (int c8 = 0; c8 < 4; ++c8) { float zz[8], r8[8]; unpack8(*(const v4u*)(Z + (size_t)row * ZW + Z_DZ + h * 32 + c8 * 8), zz);
#pragma unroll
            for (int i = 0; i < 8; ++i) r8[i] = o[c8 * 8 + i] * inv * zz[i];
            *(v4u*)(Z + (size_t)row * ZW + Z_DQ + h * 32 + c8 * 8) = pack8(r8); }
    }
}

__device__ __forceinline__ void phase_gchk(LAS unsigned char* lds_, const Args& a) {
    Frame F = make_frame(lds_); unsigned char* ws = a.ws;
    if (F.gtid < 64 * 64) { const int row = 1000 + ((F.gtid >> 6) * 531) % 30000, col = 3000 + (F.gtid & 63) * 67;
        const signed char* ar = (const signed char*)(ws + WS_N8) + (size_t)row * DM; const signed char* br = (const signed char*)(ws + WS_WG8) + (size_t)col * DM; int s = 0;
#pragma unroll 1
        for (int k = 0; k < DM; ++k) s += (int)ar[k] * (int)br[k];
        const float cm = __builtin_bit_cast(float, ((const unsigned*)(ws + WS_CTL) + CW_CMAX)[col]);
        const float logit = (float)s * ((const float*)(ws + WS_ROWS))[row] * cm * (1.0f / 127.0f);
        const int qref = (int)(255.0f / (1.0f + expf(-logit)) + 0.5f); const int qgot = (int)(ws + WS_G)[(size_t)row * NGATE + col];
        if (qref - qgot > 1 || qgot - qref > 1) atomicAdd((unsigned*)(ws + WS_CTL) + 100, 1u); }
}

typedef short s16x4 __attribute__((ext_vector_type(4)));
__device__ __forceinline__ s16x4 tr_read16(unsigned lds_byte_addr) { return __builtin_amdgcn_ds_read_tr16_b64_v4i16((LAS s16x4*)lds_byte_addr); }
__device__ __forceinline__ bf16x8 cat4(s16x4 a, s16x4 b) { bf16x8 r; r[0] = a[0]; r[1] = a[1]; r[2] = a[2]; r[3] = a[3]; r[4] = b[0]; r[5] = b[1]; r[6] = b[2]; r[7] = b[3]; return r; }
__device__ __forceinline__ bf16x8 pack_p8(const f32x4 a, const f32x4 b) {
    v4u w; w.x = pg8::cvt_pk_bf16(a[0], a[1]); w.y = pg8::cvt_pk_bf16(a[2], a[3]); w.z = pg8::cvt_pk_bf16(b[0], b[1]); w.w = pg8::cvt_pk_bf16(b[2], b[3]);
    return __builtin_bit_cast(bf16x8, w);
}

constexpr int B_NT = 34, B_KR = 0, B_KC = 36864, B_VR = 69632, B_VC = 106496;
__device__ __forceinline__ void b_stage_piece(LAS unsigned char* lds, int kv, int slot_or_ctx, bool ctx, int kk, int ch, const v4u val) {
    const int sw = kv ? (((kk >> 1) & 3) << 1) : ((kk >> 1) & 7);
    const int base = ctx ? (kv ? B_VC : B_KC) : ((kv ? B_VR : B_KR) + slot_or_ctx * 2048);
    *(LAS v4u*)(lds + base + kk * 128 + ((ch ^ sw) << 4)) = val;
}
template <int NT, bool RING>
__device__ __forceinline__ void b_segment(const unsigned ldsb, const int slot0, const bf16x8 (&Qf)[2], const int q16, const int g, const int q0, const int qpos, const bool edge, float& m, float& den, f32x4 (&O)[4]) {
    const int swk = (q16 >> 1) & 7;
    const unsigned klane = ldsb + q16 * 128;
    const unsigned kc0 = ((0 + g) ^ swk) << 4, kc1 = ((4 + g) ^ swk) << 4;
    const int kl = 4 * g + (q16 >> 2);
    const int swv = ((kl >> 1) & 3) << 1;
    const unsigned vlane = ldsb + kl * 128 + ((q16 & 1) << 3);
    unsigned vch[4];
#pragma unroll
    for (int d = 0; d < 4; ++d) vch[d] = vlane + (((2 * d + ((q16 & 3) >> 1)) ^ swv) << 4);
    const int qi = qpos - q0;
    f32x4 dv = (f32x4){0.f, 0.f, 0.f, 0.f};
#pragma unroll
    for (int s = 0; s < NT / 2; ++s) {
        unsigned kt0, vt0;
        if (RING) { int slot = slot0 + 2 * s; slot = slot >= 18 ? slot - 18 : slot; kt0 = B_KR + slot * 2048; vt0 = B_VR + slot * 2048; } else { kt0 = B_KC + 2 * s * 2048; vt0 = B_VC + 2 * s * 2048; }
        f32x4 S2[2];
#pragma unroll
        for (int h = 0; h < 2; ++h) { const bf16x8 Ka = *(const LAS bf16x8*)(klane + kt0 + h * 2048 + kc0), Kb = *(const LAS bf16x8*)(klane + kt0 + h * 2048 + kc1);
            const f32x4 a0 = __builtin_amdgcn_mfma_f32_16x16x32_bf16(Ka, Qf[0], (f32x4){0.f, 0.f, 0.f, 0.f}, 0, 0, 0);
            S2[h] = __builtin_amdgcn_mfma_f32_16x16x32_bf16(Kb, Qf[1], a0, 0, 0, 0); }
        s16x4 Vr[4][2];
#pragma unroll
        for (int d = 0; d < 4; ++d) { Vr[d][0] = tr_read16(vch[d] + vt0); Vr[d][1] = tr_read16(vch[d] + vt0 + 2048); }
        if (RING) {
#pragma unroll
            for (int h = 0; h < 2; ++h) { const int tt = 2 * s + h;
                if (edge) {
#pragma unroll
                    for (int j = 0; j < 4; ++j) { const int kpos = q0 - 128 + 16 * tt + 4 * g + j; const int dlt = kpos - qpos; const bool ok = kpos >= 0 && kpos < SEQ && dlt <= 128 && dlt >= -128; S2[h][j] = ok ? S2[h][j] : -1e30f; }
                } else if (tt < 2) {
#pragma unroll
                    for (int j = 0; j < 4; ++j) S2[h][j] = (16 * tt + 4 * g + j >= qi) ? S2[h][j] : -1e30f;
                } else if (tt >= NT - 2) {
#pragma unroll
                    for (int j = 0; j < 4; ++j) S2[h][j] = (16 * tt + 4 * g + j <= qi + 256) ? S2[h][j] : -1e30f;
                } }
        }
#pragma unroll
        for (int h = 0; h < 2; ++h) { f32x4 x = S2[h] - m;
#pragma unroll
            for (int j = 0; j < 4; ++j) x[j] = fast_exp2(x[j]);
            S2[h] = x; dv += x; }
        const bf16x8 Pf = pack_p8(S2[0], S2[1]);
#pragma unroll
        for (int d = 0; d < 4; ++d) O[d] = __builtin_amdgcn_mfma_f32_16x16x32_bf16(cat4(Vr[d][0], Vr[d][1]), Pf, O[d], 0, 0, 0);
    }
    den += (dv[0] + dv[1]) + (dv[2] + dv[3]);
}
template <bool dry = false>
__device__ __forceinline__ void phase_b_fast(LAS unsigned char* lds_, const Args& a, int l, bool last) {
    Frame F = make_frame(lds_);
    unsigned char* ws = a.ws; bf16* Z = (bf16*)(ws + WS_Z); const float* sink = a.in[I_BSINK] + l * 8;
    const int q16 = F.lane & 15, g = F.lane >> 4;
    const unsigned ldsb = (unsigned)(size_t)F.lds;
    for (int run = blockIdx.x; run < 256; run += F.G) {
        const int b = run >> 5, kh = (run >> 4) & 1, r16 = run & 15, qs0 = 8 * r16;
#pragma unroll 1
        for (int bt = 0; bt < 17; bt += 6) {
            v4u tmp[6];
#pragma unroll
            for (int k = 0; k < 6; ++k) if (bt + k < 17) { const int idx = F.tid + (bt + k) * NTHR; const int key = idx >> 4, c = idx & 15, kv = c >> 3, ch = c & 7;
                int kp = 32 * qs0 - 128 + key; kp = kp < 0 ? 0 : (kp > SEQ - 1 ? SEQ - 1 : kp);
                const size_t grow = key < 288 ? (size_t)(b * SEQ + kp) : (size_t)(MLAT + b * CTXL + (key - 288));
                tmp[k] = *(const v4u*)(Z + grow * ZW + (kv ? Z_BV : Z_BK) + kh * 64 + ch * 8); }
#pragma unroll
            for (int k = 0; k < 6; ++k) if (bt + k < 17) { const int idx = F.tid + (bt + k) * NTHR; const int key = idx >> 4, c = idx & 15, kv = c >> 3, ch = c & 7;
                if (key < 288) b_stage_piece(F.lds, kv, (2 * qs0 + 10 + (key >> 4)) % 18, false, key & 15, ch, tmp[k]);
                else b_stage_piece(F.lds, kv, 0, true, key - 288, ch, tmp[k]); }
        }
        const int nitem = (r16 < 8 && !last) ? 9 : 8;
        const int gi = F.wave >> 1, H = kh * 4 + gi, qi = 16 * (F.wave & 1) + q16;
        bf16x8 Qn[2]; v2u zn[4];
#define PB_LOADQ(it_) do { const bool ic_ = (it_) == 8; const int qs_ = ic_ ? r16 : qs0 + (it_); const size_t qr_ = ic_ ? (size_t)(MLAT + b * CTXL + qs_ * 32 + qi) : (size_t)(b * SEQ + 32 * qs_ + qi); \
            _Pragma("unroll") for (int ks = 0; ks < 2; ++ks) Qn[ks] = *(const bf16x8*)(Z + qr_ * ZW + Z_BQ + H * 64 + 32 * ks + 8 * g); \
            _Pragma("unroll") for (int d = 0; d < 4; ++d) zn[d] = *(const v2u*)(Z + qr_ * ZW + Z_BZ + H * 64 + d * 16 + 4 * g); } while (0)
        PB_LOADQ(0);
        __syncthreads();
#pragma unroll 1
        for (int it = 0; it < nitem; ++it) {
            const bool isctx = it == 8; const int qs = isctx ? r16 : qs0 + it; const int q0 = isctx ? 0 : 32 * qs;
            const bool pf = it < 7; v4u pfv = (v4u){0u, 0u, 0u, 0u}; const int pkey = F.tid >> 4, pc = F.tid & 15;
            if (pf) { int kp = 32 * (qs + 1) + 128 + pkey; kp = kp > SEQ - 1 ? SEQ - 1 : kp;
                pfv = *(const v4u*)(Z + (size_t)(b * SEQ + kp) * ZW + ((pc >> 3) ? Z_BV : Z_BK) + kh * 64 + (pc & 7) * 8); }
            const size_t qrow = isctx ? (size_t)(MLAT + b * CTXL + qs * 32 + qi) : (size_t)(b * SEQ + q0 + qi);
            bf16x8 Qf[2]; v2u zz[4];
#pragma unroll
            for (int ks = 0; ks < 2; ++ks) Qf[ks] = Qn[ks];
#pragma unroll
            for (int d = 0; d < 4; ++d) zz[d] = zn[d];
            if (it + 1 < nitem) PB_LOADQ(it + 1);
            __builtin_amdgcn_sched_barrier(0);
            const int slot0 = (2 * qs + 10) % 18;
            const int qpos = q0 + qi; const float sk = sink[H] * LOG2E;
            float mx = 0.f, den = 0.f;
            f32x4 O[4];
#pragma unroll
            for (int d = 0; d < 4; ++d) O[d] = (f32x4){0.f, 0.f, 0.f, 0.f};
            b_segment<16, false>(ldsb, slot0, Qf, q16, g, q0, qpos, false, mx, den, O);
            if (!isctx) b_segment<18, true>(ldsb, slot0, Qf, q16, g, q0, qpos, (qs < 4) || (qs >= 123), mx, den, O);
            den += __shfl_xor(den, 16); den += __shfl_xor(den, 32);
            den += fast_exp2(sk - mx);
            const float inv = 1.0f / den;
#pragma unroll
            for (int d = 0; d < 4; ++d) {
                const int dd = H * 64 + d * 16 + 4 * g;
                v2u o; o.x = pg8::cvt_pk_bf16(O[d][0] * inv * bflo(zz[d].x), O[d][1] * inv * bfhi(zz[d].x)); o.y = pg8::cvt_pk_bf16(O[d][2] * inv * bflo(zz[d].y), O[d][3] * inv * bfhi(zz[d].y));
                if (!dry) *(v2u*)(Z + qrow * ZW + Z_BQ + dd) = o; else asm volatile("" :: "v"(o.x), "v"(o.y));
            }
            __syncthreads();
            if (pf) b_stage_piece(F.lds, pc >> 3, (2 * (qs + 1) + 26 + (pkey >> 4)) % 18, false, pkey & 15, pc & 7, pfv);
            __syncthreads();
        }
#undef PB_LOADQ
    }
}

constexpr int D_KL = 0, D_KC = 36864, D_VL = 53248, D_VC = 90112, D_BIAS = 106496;
__device__ __forceinline__ void d_stage_piece(LAS unsigned char* lds, int kv, int slot, bool ctx, int kk, int ch, const v4u val) {
    const int sw = kv ? (((kk >> 2) & 1) << 1) : 0;
    const int base = ctx ? (kv ? D_VC : D_KC) : ((kv ? D_VL : D_KL) + slot * 4096);
    *(LAS v4u*)(lds + base + kk * 64 + ((ch ^ sw) << 4)) = val;
}
template <bool LOCAL>
__device__ __forceinline__ void d_segment(const unsigned ldsb, const int m0, const int cw, const bf16x8 Qf, const int q16, const int g, const int r, const int r0, const int c, const int c0,
                                          const float* rb, float& m, float& den, f32x4 (&O)[2]) {
    unsigned bbase = ldsb + D_BIAS + 4 * ((r0 - r + 7) * 31 + (cw + 4 * g - c + 15));
    if (LOCAL) asm volatile("" : "+v"(bbase));
    const unsigned klane = ldsb + q16 * 64 + (g << 4);
    const int kl = 4 * g + (q16 >> 2);
    const int swv = (g & 1) << 1;
    const unsigned vlane = ldsb + kl * 64 + ((q16 & 1) << 3);
    unsigned vch[2];
#pragma unroll
    for (int d = 0; d < 2; ++d) vch[d] = vlane + (((2 * d + ((q16 & 3) >> 1)) ^ swv) << 4);
    f32x4 dv = (f32x4){0.f, 0.f, 0.f, 0.f};
#pragma unroll
    for (int s = 0; s < 8; ++s) {
        unsigned kt0, vt0;
        if (LOCAL) { int slot = m0 + s; slot = slot >= 9 ? slot - 9 : slot; kt0 = D_KL + slot * 4096 + cw * 64; vt0 = D_VL + slot * 4096 + cw * 64; } else { kt0 = D_KC + 32 * s * 64; vt0 = D_VC + 32 * s * 64; }
        f32x4 S2[2], bv[2];
        bv[0] = (f32x4){0.f, 0.f, 0.f, 0.f}; bv[1] = bv[0];
        bf16x8 Kf[2];
#pragma unroll
        for (int h = 0; h < 2; ++h) Kf[h] = *(const LAS bf16x8*)(klane + kt0 + h * 16 * 64);
        if (LOCAL) {
#pragma unroll
            for (int h = 0; h < 2; ++h)
#pragma unroll
                for (int j = 0; j < 4; ++j) bv[h][j] = *(const LAS float*)(bbase + 4 * (s * 31 + 16 * h + j));
            asm volatile("" : "+v"(bv[0]), "+v"(bv[1]));
        }
#pragma unroll
        for (int h = 0; h < 2; ++h) S2[h] = __builtin_amdgcn_mfma_f32_16x16x32_bf16(Kf[h], Qf, bv[h], 0, 0, 0);
        s16x4 Vr[2][2];
#pragma unroll
        for (int d = 0; d < 2; ++d) { Vr[d][0] = tr_read16(vch[d] + vt0); Vr[d][1] = tr_read16(vch[d] + vt0 + 16 * 64); }
        if (LOCAL) {
#pragma unroll
            for (int h = 0; h < 2; ++h)
#pragma unroll
                for (int j = 0; j < 4; ++j) { const int cc = cw + 16 * h + 4 * g + j; const bool ok = (unsigned)(cc - c0) < 16u;
                    S2[h][j] = ok ? S2[h][j] : -1e30f; }
        }
#pragma unroll
        for (int h = 0; h < 2; ++h) { f32x4 x = S2[h] - m;
#pragma unroll
            for (int j = 0; j < 4; ++j) x[j] = fast_exp2(x[j]);
            S2[h] = x; dv += x; }
        const bf16x8 Pf = pack_p8(S2[0], S2[1]);
#pragma unroll
        for (int d = 0; d < 2; ++d) O[d] = __builtin_amdgcn_mfma_f32_16x16x32_bf16(cat4(Vr[d][0], Vr[d][1]), Pf, O[d], 0, 0, 0);
    }
    den += (dv[0] + dv[1]) + (dv[2] + dv[3]);
}
__device__ __forceinline__ int d_rbase(int rp) { const int t = 2 * rp - 4; return t < 0 ? 0 : (t > 56 ? 56 : t); }
template <bool dry = false>
__device__ __forceinline__ void phase_d_fast(LAS unsigned char* lds_, const Args& a, int l, bool last) {
    Frame F = make_frame(lds_);
    unsigned char* ws = a.ws; bf16* Z = (bf16*)(ws + WS_Z); const float* rpb = a.in[I_RPB] + (size_t)l * 16 * 15 * 31;
    const int q16 = F.lane & 15, g = F.lane >> 4;
    const unsigned ldsb = (unsigned)(size_t)F.lds;
    for (int run = blockIdx.x; run < 256; run += F.G) {
        const int h = run & 15, half = (run >> 4) & 1, b = run >> 5, rp0 = 16 * half;
        if (F.tid < 465) ((LAS float*)(F.lds + D_BIAS))[F.tid] = rpb[h * 465 + F.tid] * LOG2E;
        const int rb0 = d_rbase(rp0);
#pragma unroll 1
        for (int bt = 0; bt < 13; bt += 7) {
            v4u tmp[7];
#pragma unroll
            for (int k = 0; k < 7; ++k) if (bt + k < 13) { const int idx = F.tid + (bt + k) * NTHR; const int key = idx >> 3, c = idx & 7, kv = c >> 2, ch = c & 3;
                size_t grow;
                if (key < 576) { int gr = rb0 + (key >> 6); gr = gr > 63 ? 63 : gr; grow = (size_t)(b * SEQ + gr * 64 + (key & 63)); }
                else grow = (size_t)(MLAT + b * CTXL + (key - 576));
                tmp[k] = *(const v4u*)(Z + grow * ZW + (kv ? Z_DV : Z_DK) + h * 32 + ch * 8); }
#pragma unroll
            for (int k = 0; k < 7; ++k) if (bt + k < 13) { const int idx = F.tid + (bt + k) * NTHR; const int key = idx >> 3, c = idx & 7, kv = c >> 2, ch = c & 3;
                if (key < 576) d_stage_piece(F.lds, kv, (rb0 + (key >> 6)) % 9, false, key & 63, ch, tmp[k]);
                else d_stage_piece(F.lds, kv, 0, true, key - 576, ch, tmp[k]); }
        }
        const int nitD = last ? 16 : 17;
        bf16x8 Qn; v2u zn[2];
#define PD_LOADQ(it_) do { const bool ic_ = (it_) == 16; const int rp_ = ic_ ? rp0 + 15 : rp0 + (it_); \
            const size_t qr_ = ic_ ? (size_t)(MLAT + b * CTXL + half * 128 + F.wave * 16 + q16) : (size_t)(b * SEQ + (2 * rp_ + (F.wave >> 2)) * 64 + 16 * (F.wave & 3) + q16); \
            Qn = *(const bf16x8*)(Z + qr_ * ZW + Z_DQ + h * 32 + 8 * g); \
            _Pragma("unroll") for (int d = 0; d < 2; ++d) zn[d] = *(const v2u*)(Z + qr_ * ZW + Z_DZ + h * 32 + d * 16 + 4 * g); } while (0)
        PD_LOADQ(0);
        __syncthreads();
#pragma unroll 1
        for (int it = 0; it < nitD; ++it) {
            const bool isctx = it == 16; const int rp = isctx ? rp0 + 15 : rp0 + it;
            const int re = 2 * rp, rbase = d_rbase(rp);
            const bool pf = (it < 15) && (d_rbase(rp + 1) != rbase);
            v4u pfv[2]; pfv[0] = (v4u){0u, 0u, 0u, 0u}; pfv[1] = pfv[0];
            if (pf) {
#pragma unroll
                for (int k = 0; k < 2; ++k) { const int idx = F.tid + k * NTHR; const int key = idx >> 3, c = idx & 7; int gr = rbase + 9 + (key >> 6); gr = gr > 63 ? 63 : gr;
                    pfv[k] = *(const v4u*)(Z + (size_t)(b * SEQ + gr * 64 + (key & 63)) * ZW + ((c >> 2) ? Z_DV : Z_DK) + h * 32 + (c & 3) * 8); }
            }
            const int r = re + (F.wave >> 2), js = F.wave & 3, c = 16 * js + q16;
            const int r0 = (r - 4 < 0) ? 0 : ((r - 4 > 56) ? 56 : r - 4), c0 = (c - 8 < 0) ? 0 : ((c - 8 > 48) ? 48 : c - 8);
            const int cw = (js == 0) ? 0 : ((js == 1) ? 8 : ((js == 2) ? 24 : 32));
            const size_t qrow = isctx ? (size_t)(MLAT + b * CTXL + half * 128 + F.wave * 16 + q16) : (size_t)(b * SEQ + r * 64 + c);
            const bf16x8 Qf = Qn;
            v2u zz[2];
#pragma unroll
            for (int d = 0; d < 2; ++d) zz[d] = zn[d];
            if (it + 1 < nitD) PD_LOADQ(it + 1);
            __builtin_amdgcn_sched_barrier(0);
            const int m0 = r0 % 9;
            const float* rb = rpb + (size_t)h * 15 * 31;
            float mx = 0.f, den = 0.f;
            f32x4 O[2];
            O[0] = (f32x4){0.f, 0.f, 0.f, 0.f}; O[1] = (f32x4){0.f, 0.f, 0.f, 0.f};
            d_segment<false>(ldsb, m0, cw, Qf, q16, g, r, r0, c, c0, rb, mx, den, O);
            if (!isctx) d_segment<true>(ldsb, m0, cw, Qf, q16, g, r, r0, c, c0, rb, mx, den, O);
            den += __shfl_xor(den, 16); den += __shfl_xor(den, 32);
            const float inv = 1.0f / den;
#pragma unroll
            for (int d = 0; d < 2; ++d) {
                const int dd = h * 32 + d * 16 + 4 * g;
                v2u o; o.x = pg8::cvt_pk_bf16(O[d][0] * inv * bflo(zz[d].x), O[d][1] * inv * bfhi(zz[d].x)); o.y = pg8::cvt_pk_bf16(O[d][2] * inv * bflo(zz[d].y), O[d][3] * inv * bfhi(zz[d].y));
                if (!dry) *(v2u*)(Z + qrow * ZW + Z_DQ + dd) = o; else asm volatile("" :: "v"(o.x), "v"(o.y));
            }
            __syncthreads();
            if (pf) {
#pragma unroll
                for (int k = 0; k < 2; ++k) { const int idx = F.tid + k * NTHR; const int key = idx >> 3, c2 = idx & 7; d_stage_piece(F.lds, c2 >> 2, (rbase + 9 + (key >> 6)) % 9, false, key & 63, c2 & 3, pfv[k]); }
            }
            __syncthreads();
        }
#undef PD_LOADQ
    }
}

__device__ __forceinline__ void phase_c1_fast(LAS unsigned char* lds_, const Args& a, int l, bool last) {
    Frame F = make_frame(lds_);
    unsigned char* ws = a.ws; const bf16* Z = (const bf16*)(ws + WS_Z);
    const bf16* mt = (const bf16*)(ws + WS_MT) + (size_t)l * 4 * 2 * 128 * 128;
    bf16* fct = (bf16*)(ws + WS_NBUF); bf16* fst = (bf16*)(ws + WS_NBUF + FST_OFF); bf16* utc = (bf16*)(ws + WS_NBUF + UT_CTX_OFF); float* uch = (float*)(ws + WS_UCH);
    const int q16 = F.lane & 15, g4 = F.lane >> 4;
    const int nitem = last ? 512 : 512 + 64;
    for (int item = blockIdx.x; item < nitem; item += F.G) {
        const bool isctx = item >= 512; const int r_ = isctx ? item - 512 : item;
        const int chunk = isctx ? (r_ & 1) : (r_ & 15), g = isctx ? ((r_ >> 1) & 3) : ((r_ >> 4) & 3), b = isctx ? (r_ >> 3) : (r_ >> 6);
        {   v4u t1[4], t2[4];
#pragma unroll
            for (int k = 0; k < 4; ++k) { const int idx = F.tid + k * NTHR; const int pos = idx >> 4, ch = idx & 15; const int lpos = chunk * 128 + pos;
                const size_t r1 = isctx ? (size_t)(MLAT + b * CTXL + lpos) : (size_t)(b * SEQ + lpos), r2 = isctx ? r1 : (size_t)(b * SEQ + ((SEQ - lpos) & (SEQ - 1)));
                t1[k] = *(const v4u*)(Z + r1 * ZW + Z_FIN + g * 128 + ch * 8); t2[k] = *(const v4u*)(Z + r2 * ZW + Z_FIN + g * 128 + ch * 8); }
#pragma unroll
            for (int k = 0; k < 4; ++k) { const int idx = F.tid + k * NTHR; const int pos = idx >> 4, ch = idx & 15; const int lpos = chunk * 128 + pos;
                const int off = pos * 256 + ((ch ^ (pos & 15)) << 4);
                if (isctx) { *(LAS v4u*)(F.lds + off) = t1[k]; }
                else { float x1[8], x2[8], sp[8], sm[8]; unpack8(t1[k], x1); unpack8(t2[k], x2); const bool z0 = (lpos == 0);
#pragma unroll
                    for (int i = 0; i < 8; ++i) { sp[i] = z0 ? x1[i] : (x1[i] + x2[i]); sm[i] = x1[i] - x2[i]; }
                    *(LAS v4u*)(F.lds + off) = pack8(sp); *(LAS v4u*)(F.lds + 32768 + off) = pack8(sm); } }
        }
        __syncthreads();
        const unsigned img = (!isctx && F.wave >= 4) ? 32768u : 0u;
        bf16x8 Bf[2][4];
#pragma unroll
        for (int nt = 0; nt < 2; ++nt) { const int dp = F.wave * 32 + nt * 16 + q16;
#pragma unroll
            for (int ks = 0; ks < 4; ++ks) Bf[nt][ks] = *(const bf16x8*)(mt + ((size_t)(g * 2 + (dp >> 7)) * 128 + (dp & 127)) * 128 + 32 * ks + 8 * g4); }
#pragma unroll
        for (int m = 0; m < 8; ++m) {
            const int pos = 16 * m + q16;
            f32x4 acc[2]; acc[0] = (f32x4){0.f, 0.f, 0.f, 0.f}; acc[1] = (f32x4){0.f, 0.f, 0.f, 0.f};
            bf16x8 Af[4];
#pragma unroll
            for (int ks = 0; ks < 4; ++ks) Af[ks] = *(const LAS bf16x8*)(F.lds + img + pos * 256 + (((ks * 4 + g4) ^ (pos & 15)) << 4));
#pragma unroll
            for (int ks = 0; ks < 4; ++ks)
#pragma unroll
                for (int nt = 0; nt < 2; ++nt) acc[nt] = __builtin_amdgcn_mfma_f32_16x16x32_bf16(Af[ks], Bf[nt][ks], acc[nt], 0, 0, 0);
#pragma unroll
            for (int nt = 0; nt < 2; ++nt) { const int dp = F.wave * 32 + nt * 16 + q16, part = dp >> 7, dd = dp & 127;
                v2u o; o.x = pg8::cvt_pk_bf16(acc[nt][0], acc[nt][1]); o.y = pg8::cvt_pk_bf16(acc[nt][2], acc[nt][3]);
                bf16* dst = isctx ? utc + ((size_t)b * 512 + g * 128 + dd) * 512 + part * 256 + chunk * 128 + 16 * m + 4 * g4
                                  : (part ? fst : fct) + ((size_t)b * 512 + g * 128 + dd) * 2048 + chunk * 128 + 16 * m + 4 * g4;
                *(v2u*)dst = o; }
        }
        if (!isctx && chunk == 0 && F.tid < 128) {
            const bf16* xr = Z + (size_t)(b * SEQ + 2048) * ZW + Z_FIN + g * 128; const bf16* mr = mt + ((size_t)(g * 2 + 0) * 128 + F.tid) * 128; float s = 0.f;
#pragma unroll 4
            for (int c8 = 0; c8 < 16; ++c8) { float x[8], w[8]; unpack8(*(const v4u*)(xr + c8 * 8), x); unpack8(*(const v4u*)(mr + c8 * 8), w);
#pragma unroll
                for (int i = 0; i < 8; ++i) s += x[i] * w[i]; }
            uch[b * 512 + g * 128 + F.tid] = s;
        }
        __syncthreads();
    }
}
__device__ __forceinline__ void phase_c2_rowh(LAS unsigned char* lds_, const Args& a) {
    Frame F = make_frame(lds_);
    unsigned char* ws = a.ws; bf16* Z = (bf16*)(ws + WS_Z); const bf16* fct = (const bf16*)(ws + WS_NBUF); const float* uch = (const float*)(ws + WS_UCH);
    for (int it0 = F.gw; it0 < NB * 512; it0 += 2 * F.NGW) {
        v4u t4[2][4]; float ue[2], ze[2];
#pragma unroll
        for (int q = 0; q < 2; ++q) { const int it = it0 + q * F.NGW; const bool ok = it < NB * 512; const int itc = ok ? it : it0;
            const int b = itc >> 9, d = itc & 511; const bf16* rp = Z + ((size_t)b * SEQ + 2048) * ZW;
#pragma unroll
            for (int j = 0; j < 4; ++j) t4[q][j] = *(const v4u*)(fct + (size_t)itc * 2048 + j * 512 + F.lane * 8);
            ue[q] = uch[itc]; ze[q] = bf2f(rp[Z_FZ + d]); }
        __builtin_amdgcn_sched_barrier(0);
#pragma unroll
        for (int q = 0; q < 2; ++q) { const int it = it0 + q * F.NGW; float s = 0.f;
#pragma unroll
            for (int j = 0; j < 4; ++j) { float x[8]; unpack8(t4[q][j], x); s += ((x[0] - x[1]) + (x[2] - x[3])) + ((x[4] - x[5]) + (x[6] - x[7])); }
            s = wave_sum(s);
            if (F.lane == 0 && it < NB * 512) { const int b = it >> 9, d = it & 511; bf16* rp = Z + ((size_t)b * SEQ + 2048) * ZW;
                rp[Z_FIN + d] = (bf16)f2bf((s + ue[q]) * 0.0013810679320049757f * ze[q]); } }
    }
}

template <bool dry = false>
__device__ __forceinline__ void phase_a_fast(LAS unsigned char* lds_, const Args& a, int l, bool last) {
    Frame F = make_frame(lds_);
    unsigned char* ws = a.ws; bf16* Z = (bf16*)(ws + WS_Z); const float* rstda = (const float*)(ws + WS_RSTDA);
    const bf16* wsb = (const bf16*)(ws + WS_WSB) + (size_t)l * 4 * 128 * 128; const float* bsp = a.in[I_ABS] + l * 4 * 128; const float* gv = a.in[I_ANG] + l * 512;
    const int q16 = F.lane & 15, g4 = F.lane >> 4;
    const unsigned ldsb = (unsigned)(size_t)F.lds;
    const int nitemA = (last ? MLAT / 128 : MROWS / 128) * 8;
    v4u tmp[2]; float rs[2];
#define PA_LOAD1(it_) do { const int ch2_ = (it_) & 1, g_ = ((it_) >> 1) & 3; const size_t r0_ = (size_t)((it_) >> 3) * 128; const int cb_ = g_ * 128 + ch2_ * 64; \
        _Pragma("unroll") for (int k = 0; k < 2; ++k) { const int idx = F.tid + k * NTHR; const int s = idx >> 3, ch = idx & 7; tmp[k] = *(const v4u*)(Z + (r0_ + s) * ZW + Z_AV + cb_ + ch * 8); rs[k] = rstda[r0_ + s]; } } while (0)
    const int cb_ = (int)blockIdx.x; const bool bal = (F.G == 256) && !last;
    const bool inS = bal && ((cb_ >= 136 && cb_ < 144) || (cb_ >= 152 && cb_ < 160));
    const bool inL = bal && cb_ >= 168 && cb_ < 224 && ((cb_ - 168) & 15) < 8;
    int extra = -1;
    if (bal) { if (cb_ < 128) extra = 2048 + cb_; else if (inL) { const int k = ((cb_ - 168) >> 4) * 8 + (cb_ & 7), m = k >> 1; extra = ((m < 8) ? 136 + m : 144 + m) + 256 * (6 + (k & 1)); } }
    const int nbase = bal ? (inS ? 6 : 8) : (nitemA - cb_ + F.G - 1) / F.G, nmine = nbase + (extra >= 0 ? 1 : 0);
#define PA_ITEM(j_) (((j_) < nbase) ? cb_ + (j_) * F.G : extra)
    if (nmine > 0) PA_LOAD1(PA_ITEM(0));
    for (int ji = 0; ji < nmine; ++ji) {
        const int item = PA_ITEM(ji);
        const int ch2 = item & 1, g = (item >> 1) & 3, chunk = item >> 3; const size_t row0 = (size_t)chunk * 128; const int cbase = g * 128 + ch2 * 64;
        const int t = 16 * F.wave + q16;
        bf16x8 Bf[4];
#pragma unroll
        for (int ks = 0; ks < 4; ++ks) { const bf16* wp = wsb + ((size_t)g * 128 + t) * 128 + 32 * ks + 4 * g4;
            const v2u lo = *(const v2u*)wp, hi = *(const v2u*)(wp + 16); v4u w; w.x = lo.x; w.y = lo.y; w.z = hi.x; w.w = hi.y; Bf[ks] = __builtin_bit_cast(bf16x8, w); }
        const size_t row = row0 + t; const float bias = bsp[g * 128 + t];
        v2u uu[4], zz[4]; f32x4 gn[4];
#pragma unroll
        for (int ct = 0; ct < 4; ++ct) { const int cc = cbase + ct * 16 + 4 * g4; uu[ct] = *(const v2u*)(Z + row * ZW + Z_AU + cc); zz[ct] = *(const v2u*)(Z + row * ZW + Z_AZ + cc); gn[ct] = *(const f32x4*)(gv + cc); }
        __builtin_amdgcn_sched_barrier(0);
#pragma unroll
        for (int k = 0; k < 2; ++k) { const int idx = F.tid + k * NTHR; const int s = idx >> 3, ch = idx & 7; float x[8]; unpack8(tmp[k], x);
#pragma unroll
            for (int i = 0; i < 8; ++i) x[i] *= rs[k];
            *(LAS v4u*)(F.lds + s * 128 + ((ch ^ (((s >> 1) & 3) << 1)) << 4)) = pack8(x); }
        __syncthreads();
        if (ji + 1 < nmine) PA_LOAD1(PA_ITEM(ji + 1));
        __builtin_amdgcn_sched_barrier(0);
        f32x4 acc[4];
#pragma unroll
        for (int ct = 0; ct < 4; ++ct) acc[ct] = (f32x4){0.f, 0.f, 0.f, 0.f};
#pragma unroll
        for (int ks = 0; ks < 4; ++ks) {
            const int s0 = 32 * ks + 4 * g4 + (q16 >> 2), s1 = s0 + 16;
            s16x4 Av[4][2];
#pragma unroll
            for (int ct = 0; ct < 4; ++ct) { const int chn = 2 * ct + ((q16 & 3) >> 1);
                Av[ct][0] = tr_read16(ldsb + s0 * 128 + ((chn ^ (((s0 >> 1) & 3) << 1)) << 4) + ((q16 & 1) << 3));
                Av[ct][1] = tr_read16(ldsb + s1 * 128 + ((chn ^ (((s1 >> 1) & 3) << 1)) << 4) + ((q16 & 1) << 3)); }
#pragma unroll
            for (int ct = 0; ct < 4; ++ct) acc[ct] = __builtin_amdgcn_mfma_f32_16x16x32_bf16(cat4(Av[ct][0], Av[ct][1]), Bf[ks], acc[ct], 0, 0, 0);
        }
#pragma unroll
        for (int ct = 0; ct < 4; ++ct) {
            const int cc = cbase + ct * 16 + 4 * g4;
            v2u o; o.x = pg8::cvt_pk_bf16(bflo(uu[ct].x) * (acc[ct][0] * gn[ct][0] + bias) * bflo(zz[ct].x), bfhi(uu[ct].x) * (acc[ct][1] * gn[ct][1] + bias) * bfhi(zz[ct].x));
            o.y = pg8::cvt_pk_bf16(bflo(uu[ct].y) * (acc[ct][2] * gn[ct][2] + bias) * bflo(zz[ct].y), bfhi(uu[ct].y) * (acc[ct][3] * gn[ct][3] + bias) * bfhi(zz[ct].y));
            if (!dry) *(v2u*)(Z + row * ZW + Z_AU + cc) = o; else asm volatile("" :: "v"(o.x), "v"(o.y));
        }
        __syncthreads();
    }
#undef PA_LOAD1
#undef PA_ITEM
}

constexpr int NPHASE = 1 + 6 * DEPTH;
#ifndef REP_P2
#define REP_P2 1
#endif
#ifndef REP_M1
#define REP_M1 1
#endif
#ifndef REP_C2
#define REP_C2 1
#endif
#ifndef REP_PRO
#define REP_PRO 1
#endif
#ifndef REP_X1
#define REP_X1 1
#endif
#ifndef REP_M2L0
#define REP_M2L0 1
#endif
#ifndef DRY_A
#define DRY_A 0
#endif
#ifndef DRY_B
#define DRY_B 0
#endif
#ifndef DRY_D
#define DRY_D 0
#endif
#ifndef PROBE_P2NULL
#define PROBE_P2NULL 0
#endif
#ifndef M2_STAGGER
#define M2_STAGGER 2
#endif
#ifndef PROBE_GCHK
#define PROBE_GCHK 0
#endif
#ifndef REP_NORM
#define REP_NORM 1
#endif
__global__ void __launch_bounds__(NTHR, 2) fwd_kernel(Args args) {
    extern __shared__ __attribute__((aligned(16))) unsigned char lds_raw[];
    LAS unsigned char* const lds = (LAS unsigned char*)lds_raw;
    const int G = gridDim.x;
    unsigned char* ws = args.ws;
    volatile LAS unsigned* MISC = (volatile LAS unsigned*)(lds + MISC_OFF);
    if (threadIdx.x < 32) MISC[threadIdx.x] = 0u;
    __syncthreads();
    XcdBarrier bar = xcd_barrier_post((unsigned*)(ws + WS_CTL) + CW_BAR, MISC + 8);
    const int lo = args.ph_lo, hi = args.ph_hi;
#define IN(k) (lo <= (k) && (k) < hi)
#define SEAM(k) do { if (IN(k) && IN((k) + 1)) xcd_barrier(bar); } while (0)

    if (IN(0)) {
      for (int rep = 0; rep < REP_PRO; ++rep) {
        Frame F = make_frame(lds);
        build_costab(F);
        pro_mod(F, args.in[I_C], args.in[I_CCTX], args.in[I_WADA], args.in[I_BADA], args.in[I_NORMG], (float*)(ws + WS_MOD));
        pro_colmax(F, args.in[I_WGATE], (unsigned*)(ws + WS_CTL) + CW_CMAX);
        pro_tables(F, args.in[I_CWF], (bf16*)(ws + WS_COS2), (bf16*)(ws + WS_SIN2), (bf16*)(ws + WS_DFTC), (f32x2*)(ws + WS_ROPE), (bf16*)(ws + WS_MT), args.in[I_AWS], (bf16*)(ws + WS_WSB));
        __syncthreads();
      }
    }
    SEAM(0);
#pragma unroll 1
    for (int l = 0; l < DEPTH; ++l) {
        const int pb = 1 + 6 * l;
        if (IN(pb + 0)) { if (l == 0) phase_convert(lds, args, 0, 0, CV_ALL, nullptr); for (int rep = 0; rep < REP_NORM; ++rep) { phase_norm(lds, args, l); __syncthreads(); } }
        SEAM(pb + 0);
        if (IN(pb + 1)) {
          if (PROBE_P2NULL) {
            PlainProb P{(const char*)(ws + WS_NBUF), (const char*)(ws + WS_WCAT), DM * 2, DM * 2, DM};
            pg8::StaticOrder S; S.init(MROWS / 256, N1 / 256, G, (int)blockIdx.x);
            EpiNull E{};
            pg8::gemm_phase<PlainProb, EpiNull, true, true>(lds, P, S, E);
          }
#pragma unroll 1
          for (int rep = 0; rep < REP_P2; ++rep) {
            PlainProb P{(const char*)(ws + WS_NBUF), (const char*)(ws + WS_WCAT), DM * 2, DM * 2, DM};
            P2Order S; S.init(G, (int)blockIdx.x, l == DEPTH - 1, i8_layer(l) ? ZW / 256 : N1 / 256);
            EpiP2 E{(bf16*)(ws + WS_Z), ws + WS_G, args.in[I_BQG] + l * 64, args.in[I_BKG] + l * 64, args.in[I_DQG] + l * 32, args.in[I_DKG] + l * 32, (const f32x2*)(ws + WS_ROPE)};
            const int nfull = S.full.nwg / G, nrem = S.full.nwg - nfull * G;
            const bool halves = (l != DEPTH - 1) && nrem > 0 && 2 * nrem <= G;
            if (halves) S.maxi = nfull;
            pg8::gemm_phase<PlainProb, EpiP2, true, true, P2Order>(lds, P, S, E);
            if (halves) {
                const int hc = (int)blockIdx.x; const bool act = hc < 2 * nrem;
                pg8::StaticOrder T1 = S.full; T1.c = act ? (hc >> 1) : 0; pg8::Unit hu; hu.pm = 0; hu.pn = 0; (void)T1.next(nfull, hu);
                const int rowbase = hu.pm * 256 + (hc & 1) * 128;
                pg8::gemm_phase_half<EpiP2>(lds, P.A + (size_t)rowbase * P.lda, P.B + (size_t)hu.pn * 256 * P.ldb, P.lda, P.ldb, P.K, act, E, rowbase, hu.pn);
            }
            if (i8_layer(l)) {
                PlainProb Pg{(const char*)(ws + WS_N8), (const char*)(ws + WS_WG8), DM, DM, DM / 2};
                pg8::StaticOrder Sg; Sg.init((l == DEPTH - 1) ? MLAT / 256 : MROWS / 256, NGATE / 256, G, (int)blockIdx.x);
                EpiGate Eg{ws + WS_G, (const float*)(ws + WS_ROWS), (const unsigned*)(ws + WS_CTL) + CW_CMAX + (size_t)l * 8192};
                pg8::gemm_phase<PlainProb, EpiGate, true, true, pg8::StaticOrder, true>(lds, Pg, Sg, Eg);
            }
          }
          if (l > 0) phase_convert(lds, args, l, CV_IN + CV_GT + CV_BR, CV_ALL, (unsigned*)(ws + WS_CTL) + CW_CVQ + 64 * (2 * l));
        }
        SEAM(pb + 1);
        if (PROBE_GCHK && l == 0 && IN(pb + 2)) phase_gchk(lds, args);
        if (IN(pb + 2)) { for (int rep = 0; rep < REP_X1; ++rep) { phase_x1(lds, args, l, l == DEPTH - 1); phase_c1_fast(lds, args, l, l == DEPTH - 1); } }
        SEAM(pb + 2);
        if (IN(pb + 3)) {
#pragma unroll 1
          for (int rep = 0; rep < REP_C2; ++rep) {
            {
                pg8::C2Prob P{(const char*)(ws + WS_COS2), (const char*)(ws + WS_SIN2), (const char*)(ws + WS_NBUF), (const char*)(ws + WS_NBUF + FST_OFF), (const float*)(ws + WS_UCH), (bf16*)(ws + WS_Z), 0.0013810679320049757f  };
                pg8::gemm_phase_c2(lds, P, G, (int)blockIdx.x);
                phase_c2_rowh(lds, args);
            }
            if (l + 1 < DEPTH) {
                DftCtxProb P{(const char*)(ws + WS_DFTC), (const char*)(ws + WS_NBUF + UT_CTX_OFF), 512 * 2, 512 * 2, 512};
                CtxDftOrder S{G, (int)blockIdx.x};
                EpiC2 E{(bf16*)(ws + WS_Z), MLAT, 0.005524271728019903f  };
                pg8::gemm_phase<DftCtxProb, EpiC2, true, true, CtxDftOrder>(lds, P, S, E);
            }
          }
#pragma unroll 1
            for (int rep = 0; rep < DRY_A; ++rep) phase_a_fast<true>(lds, args, l, l == DEPTH - 1);
            phase_a_fast(lds, args, l, l == DEPTH - 1);
#pragma unroll 1
            for (int rep = 0; rep < DRY_B; ++rep) phase_b_fast<true>(lds, args, l, l == DEPTH - 1);
            phase_b_fast(lds, args, l, l == DEPTH - 1);
#pragma unroll 1
            for (int rep = 0; rep < DRY_D; ++rep) phase_d_fast<true>(lds, args, l, l == DEPTH - 1);
            phase_d_fast(lds, args, l, l == DEPTH - 1);
        }
        SEAM(pb + 3);
        if (IN(pb + 4)) {
#pragma unroll 1
          for (int rep = 0; rep < REP_M1; ++rep) {
            pg8::M1Prob P{(const char*)(ws + WS_Z), (const char*)(ws + WS_WBR), ws + WS_G, (bf16*)(ws + WS_NBUF)};
            pg8::gemm_phase_m1ms(lds, P, G, (int)blockIdx.x, (l == DEPTH - 1) ? MLAT / 256 : MROWS / 256);
          }
        }
        SEAM(pb + 4);
        if (IN(pb + 5)) {
#pragma unroll 1
          for (int rep = 0; rep < ((l == 0) ? REP_M2L0 : 1); ++rep) {
            PlainProb P{(const char*)(ws + WS_NBUF), (const char*)(ws + WS_WOUT), DM * 2, DM * 2, DM};
            pg8::StaticOrder S; S.init((l == DEPTH - 1) ? MLAT / 256 : MROWS / 256, DM / 256, G, (int)blockIdx.x, 4);
            EpiM2 E{l ? args.out : args.in[I_X], args.out, l ? (const float*)(ws + WS_HC) : args.in[I_CTX], (float*)(ws + WS_HC), (const float*)(ws + WS_MOD) + (size_t)l * 9 * 6144, (PROBE_GCHK && l == DEPTH - 1) ? (const unsigned*)(ws + WS_CTL) + 100 : nullptr};
            pg8::gemm_phase<PlainProb, EpiM2, true, true>(lds, P, S, E);
          }
          if (l + 1 < DEPTH) phase_convert(lds, args, l + 1, 0, CV_IN + CV_GT + CV_BR, (unsigned*)(ws + WS_CTL) + CW_CVQ + 64 * (2 * l + 1));
        }
        SEAM(pb + 5);
    }
#undef IN
#undef SEAM
}

#ifndef MK_SPLIT
#define MK_SPLIT 0
#endif
extern "C" void kernel_launch(void* const* d_in, const int* in_sizes, int n_in, void* d_out, int out_size, void* d_ws, size_t ws_size, hipStream_t stream) {
    static int grid = 0;
    if (grid == 0) {
        if (n_in != 21 || out_size != MLAT * DM || ws_size < WS_END) { fprintf(stderr, "kernel_launch: unexpected shapes (n_in %d out %d ws %zu)\n", n_in, out_size, ws_size); grid = -1; return; }
        int dev = 0, cus = 0, per_cu = 0;
        if (hipGetDevice(&dev) != hipSuccess || hipDeviceGetAttribute(&cus, hipDeviceAttributeMultiprocessorCount, dev) != hipSuccess) { grid = -1; return; }
        if (hipFuncSetAttribute((const void*)fwd_kernel, hipFuncAttributeMaxDynamicSharedMemorySize, LDS_BYTES) != hipSuccess) { fprintf(stderr, "kernel_launch: hipFuncSetAttribute failed\n"); grid = -1; return; }
        if (hipOccupancyMaxActiveBlocksPerMultiprocessor(&per_cu, (const void*)fwd_kernel, NTHR, LDS_BYTES) != hipSuccess || per_cu < 1) { fprintf(stderr, "kernel_launch: occupancy query says %d\n", per_cu); }
        (void)hipGetLastError();
        grid = cus;
    }
    if (grid < 0) return;
    if (hipMemsetAsync((char*)d_ws + WS_CTL, 0, CTL_ZERO_BYTES, stream) != hipSuccess) return;
    Args a{};
    for (int i = 0; i < 21; ++i) a.in[i] = (const float*)d_in[i];
    a.out = (float*)d_out; a.ws = (unsigned char*)d_ws;
#if MK_SPLIT
    for (int p = 0; p < NPHASE; ++p) { a.ph_lo = p; a.ph_hi = p + 1; hipLaunchKernelGGL(fwd_kernel, dim3(grid), dim3(NTHR), LDS_BYTES, stream, a); }
#else
    a.ph_lo = 0; a.ph_hi = NPHASE; hipLaunchKernelGGL(fwd_kernel, dim3(grid), dim3(NTHR), LDS_BYTES, stream, a);
#endif
}
```
